# Optimizing an MI355X kernel written in HIP

```python
import jax, jax.numpy as jnp
from jax import lax
import numpy as np

D_MODEL = 1024
BATCH = 8
SEQ = 2048
DEPTH = 4
DEC_BATCH = 128
DEC_SEQ = 8
PAST_LEN = 16384
PAGE_SIZE = 128

D_MIX = D_MODEL
D_POOL = D_MIX // 2
POOL_WINDOWS = (2, 4, 8, 16)
POOL_GROUPS = len(POOL_WINDOWS)
POOL_GC = D_POOL // POOL_GROUPS
POOL_BUF = max(POOL_WINDOWS) - 1
DN_DK = 128
DN_DV = 128
DN_HEADS = (D_MIX - D_POOL) // DN_DV
D_DN = DN_HEADS * DN_DV
D_QKV = DN_HEADS * (2 * DN_DK + DN_DV)
DN_CONV = 4
DN_CHUNK = 64
IN_AB = D_POOL + D_QKV + D_DN + 2 * DN_HEADS
SC_CONV = 3
D_FF = 2816
FFN_CONV = 3
N_AB = (DEPTH + 1) // 2
N_C = DEPTH // 2
EPS = 1e-6

kernel_name = 'hybrid_pool_gdn_shortconv_convffn_step'


def rmsnorm(x, w):
    xf = x.astype(jnp.float32)
    y = xf * lax.rsqrt(jnp.mean(xf * xf, axis=-1, keepdims=True) + EPS)
    return (y * w.astype(jnp.float32)).astype(x.dtype)


def l2norm(x):
    return x * lax.rsqrt(jnp.sum(x * x, axis=-1, keepdims=True) + EPS)


def causal_dwconv(u, buf, w):
    width = w.shape[0]
    t_len = u.shape[1]
    ext = jnp.concatenate([buf.astype(u.dtype), u], axis=1)
    y = ext[:, 0:t_len] * w[0]
    for j in range(1, width):
        y = y + ext[:, j:j + t_len] * w[j]
    return y, ext[:, ext.shape[1] - (width - 1):]


def pool_mixer(u, buf, pool_w, pool_scale, pos0):
    b, t_len, _ = u.shape
    ext = jnp.concatenate([buf.astype(u.dtype), u], axis=1)
    cs = jnp.cumsum(ext.astype(jnp.float32), axis=1)
    cs = jnp.concatenate([jnp.zeros_like(cs[:, :1]), cs], axis=1)
    end = cs[:, POOL_BUF + 1:]
    pos = jnp.arange(t_len) + pos0 + 1
    means = []
    for gi, win in enumerate(POOL_WINDOWS):
        sl = slice(gi * POOL_GC, (gi + 1) * POOL_GC)
        start = cs[:, POOL_BUF + 1 - win:POOL_BUF + 1 - win + t_len, sl]
        cnt = jnp.minimum(pos, win).astype(jnp.float32)[None, :, None]
        means.append((end[..., sl] - start) / cnt)
    y = jnp.concatenate(means, axis=-1) - u.astype(jnp.float32)
    y = y.astype(u.dtype).reshape(b, t_len, POOL_GROUPS, POOL_GC)
    y = jnp.einsum('btgc,gcd->btgd', y, pool_w).reshape(b, t_len, D_POOL)
    return y * pool_scale, ext[:, t_len:]


def gated_delta_chunked(q, k, v, g, beta, h0):
    b, t_len, nh, dk = q.shape
    dv = v.shape[-1]
    csz = min(DN_CHUNK, t_len)
    n = -(-t_len // csz)
    pad = n * csz - t_len

    def blocks(a):
        a = jnp.pad(a, [(0, 0), (0, pad)] + [(0, 0)] * (a.ndim - 2))
        a = a.reshape((b, n, csz) + a.shape[2:])
        return jnp.moveaxis(a, 3, 1)

    q, k, v, g, beta = (blocks(a) for a in (q, k, v, g, beta))
    gc = jnp.cumsum(g, axis=-1)
    idx = jnp.arange(csz)
    incl = idx[:, None] >= idx[None, :]
    strict = idx[:, None] > idx[None, :]
    diff = gc[..., :, None] - gc[..., None, :]
    decay = jnp.where(incl, jnp.exp(jnp.where(incl, diff, 0.0)), 0.0)
    kk = jnp.einsum('bhnik,bhnjk->bhnij', k, k)
    lmat = jnp.where(strict, beta[..., :, None] * kk * decay, 0.0)
    amat = lmat + jnp.eye(csz, dtype=lmat.dtype)
    gam = jnp.exp(gc)
    rhs = jnp.concatenate([(beta * gam)[..., None] * k, beta[..., None] * v], axis=-1)
    sol = lax.linalg.triangular_solve(amat, rhs, left_side=True, lower=True, unit_diagonal=True)
    w_blk, u_blk = sol[..., :dk], sol[..., dk:]
    aqk = jnp.einsum('bhnik,bhnjk->bhnij', q, k) * decay
    qg = q * gam[..., None]
    kd = k * jnp.exp(gc[..., -1:] - gc)[..., None]
    g_end = gam[..., -1]

    def step(hs, xs):
        w_c, u_c, a_c, q_c, k_c, ge = xs
        u_true = u_c - jnp.einsum('bhik,bhkv->bhiv', w_c, hs)
        o_c = jnp.einsum('bhik,bhkv->bhiv', q_c, hs) + jnp.einsum('bhij,bhjv->bhiv', a_c, u_true)
        hs = ge[..., None, None] * hs + jnp.einsum('bhik,bhiv->bhkv', k_c, u_true)
        return hs, o_c

    xs = tuple(jnp.moveaxis(a, 2, 0) for a in (w_blk, u_blk, aqk, qg, kd, g_end))
    h_end, o = lax.scan(step, h0, xs)
    o = jnp.transpose(o, (1, 0, 3, 2, 4)).reshape(b, n * csz, nh, dv)[:, :t_len]
    return o, h_end


def ab_mixer(h, pool_buf, conv_buf, dn_state, w_in, pool_w, pool_scale, conv_w, a_log, dt_bias, norm_w, w_out, pos0):
    b, t_len, _ = h.shape
    proj = h @ w_in
    o0 = D_POOL
    u_pool = proj[..., :o0]
    qkv = proj[..., o0:o0 + D_QKV]
    o0 += D_QKV
    z = proj[..., o0:o0 + D_DN]
    o0 += D_DN
    b_lin = proj[..., o0:o0 + DN_HEADS]
    a_lin = proj[..., o0 + DN_HEADS:]
    y_pool, new_pool = pool_mixer(u_pool, pool_buf, pool_w, pool_scale, pos0)
    qkv_c, new_conv = causal_dwconv(qkv, conv_buf, conv_w)
    qkv_c = jax.nn.silu(qkv_c.astype(jnp.float32))
    dq = DN_HEADS * DN_DK
    q = l2norm(qkv_c[..., :dq].reshape(b, t_len, DN_HEADS, DN_DK)) * (DN_DK ** -0.5)
    k = l2norm(qkv_c[..., dq:2 * dq].reshape(b, t_len, DN_HEADS, DN_DK))
    v = qkv_c[..., 2 * dq:].reshape(b, t_len, DN_HEADS, DN_DV)
    beta = jax.nn.sigmoid(b_lin.astype(jnp.float32))
    g = -jnp.exp(a_log.astype(jnp.float32)) * jax.nn.softplus(a_lin.astype(jnp.float32) + dt_bias.astype(jnp.float32))
    o, new_state = gated_delta_chunked(q, k, v, g, beta, dn_state.astype(jnp.float32))
    on = o * lax.rsqrt(jnp.mean(o * o, axis=-1, keepdims=True) + EPS) * norm_w.astype(jnp.float32)
    on = on * jax.nn.silu(z.astype(jnp.float32).reshape(b, t_len, DN_HEADS, DN_DV))
    y_dn = on.reshape(b, t_len, D_DN).astype(h.dtype)
    y = jnp.concatenate([y_pool.astype(h.dtype), y_dn], axis=-1) @ w_out
    return y, new_pool, new_conv, new_state.astype(dn_state.dtype)


def sconv_mixer(h, buf, w_in, conv_w, w_out):
    proj = h @ w_in
    b_gate, c_gate, hv = proj[..., :D_MODEL], proj[..., D_MODEL:2 * D_MODEL], proj[..., 2 * D_MODEL:]
    yc, new_buf = causal_dwconv(c_gate * hv, buf, conv_w)
    return (b_gate * yc) @ w_out, new_buf


def conv_ffn(h, buf, w_up, conv_w, w_down):
    up = h @ w_up
    gate, val = up[..., :D_FF], up[..., D_FF:]
    gc, new_buf = causal_dwconv(gate, buf, conv_w)
    return (jax.nn.silu(gc) * val) @ w_down, new_buf


def trunk(x, pool_buf, dnconv_buf, dn_state, sconv_buf, ffn_buf, pos0,
          norm_mix, norm_ffn, norm_final, w_in_ab, pool_w, pool_scale, dn_conv_w, dn_a_log,
          dn_dt_bias, dn_norm_w, w_out_ab, w_in_c, sc_conv_w, w_out_c, w_up, ffn_conv_w, w_down):
    new_pool, new_dnconv, new_dn, new_sconv, new_ffn = [], [], [], [], []
    for l in range(DEPTH):
        i = l // 2
        h = rmsnorm(x, norm_mix[l])
        if l % 2 == 0:
            y, p_b, c_b, s_b = ab_mixer(h, pool_buf[i], dnconv_buf[i], dn_state[i], w_in_ab[i], pool_w[i],
                                        pool_scale[i], dn_conv_w[i], dn_a_log[i], dn_dt_bias[i],
                                        dn_norm_w[i], w_out_ab[i], pos0)
            new_pool.append(p_b)
            new_dnconv.append(c_b)
            new_dn.append(s_b)
        else:
            y, sc_b = sconv_mixer(h, sconv_buf[i], w_in_c[i], sc_conv_w[i], w_out_c[i])
            new_sconv.append(sc_b)
        x = x + y
        h = rmsnorm(x, norm_ffn[l])
        y, f_b = conv_ffn(h, ffn_buf[l], w_up[l], ffn_conv_w[l], w_down[l])
        new_ffn.append(f_b)
        x = x + y
    x = rmsnorm(x, norm_final)
    return (x, jnp.stack(new_pool), jnp.stack(new_dnconv), jnp.stack(new_dn),
            jnp.stack(new_sconv), jnp.stack(new_ffn))


def setup_inputs(seed: int = 0) -> dict:
    key = jax.random.key(seed)
    ks = jax.random.split(key, 24)
    f32 = jnp.float32
    nrm = lambda k, shape, s: jax.random.normal(k, shape, f32) * s
    dt = jnp.exp(jax.random.uniform(ks[15], (N_AB, DN_HEADS), f32, np.log(1e-3), np.log(1e-1)))
    return {
        'x_prompt': nrm(ks[0], (BATCH, SEQ, D_MODEL), 1.0),
        'x_sample': nrm(ks[1], (DEC_BATCH, DEC_SEQ, D_MODEL), 1.0),
        'state_pool': nrm(ks[2], (N_AB, DEC_BATCH, POOL_BUF, D_POOL), 1.0),
        'state_dn_conv': nrm(ks[3], (N_AB, DEC_BATCH, DN_CONV - 1, D_QKV), 1.0),
        'state_dn': nrm(ks[4], (N_AB, DEC_BATCH, DN_HEADS, DN_DK, DN_DV), 0.3),
        'state_sconv': nrm(ks[5], (N_C, DEC_BATCH, SC_CONV - 1, D_MODEL), 1.0),
        'state_ffn_conv': nrm(ks[6], (DEPTH, DEC_BATCH, FFN_CONV - 1, D_FF), 1.0),
        'norm_mix': 1.0 + nrm(ks[7], (DEPTH, D_MODEL), 0.02),
        'norm_ffn': 1.0 + nrm(ks[8], (DEPTH, D_MODEL), 0.02),
        'norm_final': 1.0 + nrm(ks[9], (D_MODEL,), 0.02),
        'w_in_ab': nrm(ks[10], (N_AB, D_MODEL, IN_AB), D_MODEL ** -0.5),
        'pool_w': nrm(ks[11], (N_AB, POOL_GROUPS, POOL_GC, POOL_GC), POOL_GC ** -0.5),
        'pool_scale': 1.0 + nrm(ks[12], (N_AB, D_POOL), 0.02),
        'dn_conv_w': nrm(ks[13], (N_AB, DN_CONV, D_QKV), DN_CONV ** -0.5),
        'dn_a_log': jnp.log(jax.random.uniform(ks[14], (N_AB, DN_HEADS), f32, 1.0, 16.0)),
        'dn_dt_bias': dt + jnp.log(-jnp.expm1(-dt)),
        'dn_norm_w': 1.0 + nrm(ks[16], (N_AB, DN_DV), 0.02),
        'w_out_ab': nrm(ks[17], (N_AB, D_MIX, D_MODEL), D_MIX ** -0.5),
        'w_in_c': nrm(ks[18], (N_C, D_MODEL, 3 * D_MODEL), D_MODEL ** -0.5),
        'sc_conv_w': nrm(ks[19], (N_C, SC_CONV, D_MODEL), SC_CONV ** -0.5),
        'w_out_c': nrm(ks[20], (N_C, D_MODEL, D_MODEL), D_MODEL ** -0.5),
        'w_up': nrm(ks[21], (DEPTH, D_MODEL, 2 * D_FF), D_MODEL ** -0.5),
        'ffn_conv_w': nrm(ks[22], (DEPTH, FFN_CONV, D_FF), FFN_CONV ** -0.5),
        'w_down': nrm(ks[23], (DEPTH, D_FF, D_MODEL), D_FF ** -0.5),
    }


def reference(x_prompt, x_sample, state_pool, state_dn_conv, state_dn, state_sconv, state_ffn_conv,
              norm_mix, norm_ffn, norm_final, w_in_ab, pool_w, pool_scale, dn_conv_w, dn_a_log,
              dn_dt_bias, dn_norm_w, w_out_ab, w_in_c, sc_conv_w, w_out_c, w_up, ffn_conv_w, w_down):
    weights = (norm_mix, norm_ffn, norm_final, w_in_ab, pool_w, pool_scale, dn_conv_w, dn_a_log,
               dn_dt_bias, dn_norm_w, w_out_ab, w_in_c, sc_conv_w, w_out_c, w_up, ffn_conv_w, w_down)
    bp = x_prompt.shape[0]
    dtp = x_prompt.dtype
    zp_pool = jnp.zeros((N_AB, bp, POOL_BUF, D_POOL), dtp)
    zp_dnconv = jnp.zeros((N_AB, bp, DN_CONV - 1, D_QKV), dtp)
    zp_dn = jnp.zeros((N_AB, bp, DN_HEADS, DN_DK, DN_DV), state_dn.dtype)
    zp_sconv = jnp.zeros((N_C, bp, SC_CONV - 1, D_MODEL), dtp)
    zp_ffn = jnp.zeros((DEPTH, bp, FFN_CONV - 1, D_FF), dtp)
    y_prompt, new_pool_p, new_dnconv_p, new_dn_p, new_sconv_p, new_ffnconv_p = trunk(
        x_prompt, zp_pool, zp_dnconv, zp_dn, zp_sconv, zp_ffn, 0, *weights)
    y_sample, new_pool_s, new_dnconv_s, new_dn_s, new_sconv_s, new_ffnconv_s = trunk(
        x_sample, state_pool, state_dn_conv, state_dn, state_sconv, state_ffn_conv, PAST_LEN, *weights)
    return (y_prompt, y_sample, new_pool_p, new_pool_s, new_dnconv_p, new_dnconv_s, new_dn_p, new_dn_s,
            new_sconv_p, new_sconv_s, new_ffnconv_p, new_ffnconv_s)
```

```cpp
#include <hip/hip_runtime.h>
#include <hip/hip_cooperative_groups.h>
#include <cstdio>
#include <cstdint>
namespace cg = cooperative_groups;

#define LAS __attribute__((address_space(3)))
#define GAS __attribute__((address_space(1)))
#define DI __device__ __forceinline__

#define XB_TMO      128
#define XB_XCNT(j)  (256  + 64 * (j))
#define XB_XSUB(j)  (1280 + 64 * (j))
#define XB_XGEN(j)  (2304 + 64 * (j))
#define XB_TOP      3328
#define XB_TOPGEN   3392
#define XCD_BAR_WORDS 3456
#define XB_SPIN_CAP (1u << 18)

__device__ __forceinline__ unsigned xb_ld(unsigned* p)              { return __hip_atomic_load(p, __ATOMIC_RELAXED, __HIP_MEMORY_SCOPE_AGENT); }
__device__ __forceinline__ unsigned xb_add(unsigned* p, unsigned v) { return __hip_atomic_fetch_add(p, v, __ATOMIC_RELAXED, __HIP_MEMORY_SCOPE_AGENT); }
__device__ __forceinline__ unsigned xb_xcc_id() { return (unsigned)__builtin_amdgcn_s_getreg((3 << 11) | 20) & 0xFu; }
#define XB_SPIN(cond, bar) do { unsigned _sp = 0; while (cond) { __builtin_amdgcn_s_sleep(1); \
    if ((++_sp & 255u) == 0u) { if (xb_ld(&(bar)[XB_TMO])) break; if (_sp > XB_SPIN_CAP) { atomicAdd(&(bar)[XB_TMO], 1u); break; } } } } while (0)

struct XcdBarrier { unsigned* bar; unsigned x; volatile LAS unsigned* st; };

__device__ __forceinline__ XcdBarrier xcd_barrier_post(unsigned* bar, volatile LAS unsigned* st) {
    XcdBarrier b; b.bar = bar; b.x = xb_xcc_id(); b.st = st;
    if (threadIdx.x == 0) (void)xb_add(&bar[XB_XCNT(b.x)], 1u);
    return b;
}
__device__ __forceinline__ void xcd_barrier_complete(unsigned* bar, unsigned x, unsigned& nloc, unsigned& nx) {
    const unsigned G = gridDim.x * gridDim.y * gridDim.z;
    unsigned sum, cnt, mine, sp = 0u;
    for (;;) {
        sum = 0u; cnt = 0u; mine = 0u;
#pragma unroll
        for (unsigned j = 0; j < 16; ++j) { const unsigned c = xb_ld(&bar[XB_XCNT(j)]); sum += c; cnt += (c > 0u) ? 1u : 0u; mine = (j == x) ? c : mine; }
        if (sum == G) break;
        __builtin_amdgcn_s_sleep(1);
        if ((++sp & 255u) == 0u) { if (xb_ld(&bar[XB_TMO])) break; if (sp > XB_SPIN_CAP) { atomicAdd(&bar[XB_TMO], 1u); break; } }
    }
    nloc = mine > 0u ? mine : 1u; nx = cnt > 0u ? cnt : 1u;
}
__device__ __forceinline__ void xcd_barrier(const XcdBarrier& b) {
    asm volatile("s_waitcnt vmcnt(0)" ::: "memory");
    __syncthreads();
    if (threadIdx.x == 0) {
        unsigned* bar = b.bar;
        __builtin_amdgcn_s_waitcnt(0);
        unsigned nloc = b.st[0], nx = b.st[1];
        if (nloc == 0u) { xcd_barrier_complete(bar, b.x, nloc, nx); b.st[0] = nloc; b.st[1] = nx; }
        const unsigned old = xb_add(&bar[XB_XSUB(b.x)], 1u);
        const unsigned gen = old / nloc;
        if (old + 1u == (gen + 1u) * nloc) {
            __builtin_amdgcn_fence(__ATOMIC_RELEASE, "agent");
            asm volatile("s_waitcnt vmcnt(0)" ::: "memory");
            const unsigned og = xb_add(&bar[XB_TOP], 1u);
            const unsigned tg = og / nx;
            if (og + 1u == (tg + 1u) * nx) xb_add(&bar[XB_TOPGEN], 1u);
            else XB_SPIN(xb_ld(&bar[XB_TOPGEN]) == tg, bar);
            __builtin_amdgcn_fence(__ATOMIC_ACQUIRE, "agent");
            xb_add(&bar[XB_XGEN(b.x)], 1u);
            asm volatile("s_waitcnt vmcnt(0)" ::: "memory");
        } else {
            XB_SPIN(xb_ld(&bar[XB_XGEN(b.x)]) == gen, bar);
            __builtin_amdgcn_fence(__ATOMIC_ACQUIRE, "agent");
            asm volatile("s_waitcnt vmcnt(0)" ::: "memory");
        }
    }
    __syncthreads();
}

namespace pg8 {
#define PG8_LAS __attribute__((address_space(3)))
typedef unsigned short bf16_t;
typedef short bf16x8 __attribute__((ext_vector_type(8)));
typedef float f32x4 __attribute__((ext_vector_type(4)));
typedef unsigned u32x4 __attribute__((ext_vector_type(4)));
constexpr int BM = 256, BK = 64, HALF = 128, HTB = HALF * BK * 2  , STAGE_BYTES = 8 * HTB, NXCD = 8, WGM = 8;

__host__ __device__ __forceinline__ int lds_byte(int r, int c) { const int st = (r >> 4) * 2 + (c >> 5), rr = r & 15, cc = c & 31, ob = rr * 64 + cc * 2; return st * 1024 + (ob ^ (((ob >> 9) & 1) << 5)); }
__host__ __device__ __forceinline__ void stage_rc(int b, int& R, int& C) { const int st = b / 1024, sb = b % 1024, swz = sb ^ (((sb >> 9) & 1) << 5); R = (st >> 1) * 16 + swz / 64; C = (st & 1) * 32 + (swz % 64) / 2; }
__host__ __device__ __forceinline__ int perm32(int rho) { const int n = rho >> 4, i = rho & 15; return 8 * (i >> 2) + 4 * n + (i & 3); }

struct Unit { int pm, pn; };
struct Gemm { const bf16_t* A; const bf16_t* Bt; int M, N, K; };

struct TripleOrder {
    int G, c;
    __device__ __forceinline__ void init(int G_, int c_) { G = G_; c = c_; }
    __device__ __forceinline__ static void owner(int trip, int& pm, int& t) { const int x = trip & 7, slot = trip >> 3; pm = x * 8 + (slot >> 2); t = slot & 3; }
    __device__ __forceinline__ bool next(int i, Unit& u) const {
        const int trip = c + (i / 3) * G; if (trip >= 256) return false;
        int pm, t; owner(trip, pm, t); const int k = i % 3;
        u.pm = pm; u.pn = k == 0 ? t : 4 + 2 * t + (k - 1); return true;
    }
    __device__ __forceinline__ void a_ready(const Unit&) const {}
    __device__ __forceinline__ void done(const Unit&) const {}
};
struct StaticOrder {
    int nM, nN, nwg, G, c;
    __host__ __device__ __forceinline__ void init(int M, int N, int G_, int c_) { nM = M / BM; nN = N / BM; nwg = nM * nN; G = G_; c = c_; }
    __host__ __device__ __forceinline__ bool next(int i, Unit& u) const {
        const long L = (long)i * G + c; if (L >= nwg) return false;
        int wgid = (int)L; { const int q = nwg / NXCD, r = nwg % NXCD, xcd = wgid % NXCD, off = wgid / NXCD; wgid = (xcd < r ? xcd * (q + 1) : r * (q + 1) + (xcd - r) * q) + off; }
        const int nig = WGM * nN, gid = wgid / nig, fm = gid * WGM, gsz = (nM - fm) < WGM ? (nM - fm) : WGM;
        u.pm = fm + ((wgid % nig) % gsz); u.pn = (wgid % nig) / gsz; return true;
    }
    __device__ __forceinline__ void a_ready(const Unit&) const {}
    __device__ __forceinline__ void done(const Unit&) const {}
};

typedef __bf16 bf16x2_t __attribute__((ext_vector_type(2)));
typedef float f32x2_t __attribute__((ext_vector_type(2)));
__device__ __forceinline__ unsigned cvt_pk_bf16(float lo, float hi) { f32x2_t v = {lo, hi}; return __builtin_bit_cast(unsigned, __builtin_convertvector(v, bf16x2_t)); }

struct EpiBf16 {
    static constexpr bool PERM = true, AFTER_DRAIN = false, INIT = false, PREFETCH = false, MICRO = false;
    bf16_t* O; int ldc;
    __device__ __forceinline__ void operator()(const f32x4 (&acc)[2][2][4][2], const Unit& u, int wr, int wc, int fr, int fq) const {
        const int row0 = u.pm * BM + wr * 64 + fr; const int col0 = u.pn * BM + wc * 32 + 8 * fq;
#pragma unroll
        for (int ai = 0; ai < 2; ++ai)
#pragma unroll
            for (int m = 0; m < 4; ++m) { bf16_t* rowp = O + (size_t)(row0 + ai * HALF + m * 16) * ldc + col0;
#pragma unroll
                for (int bj = 0; bj < 2; ++bj) { const f32x4 v0 = acc[ai][bj][m][0], v1 = acc[ai][bj][m][1];
                    u32x4 w; w.x = cvt_pk_bf16(v0[0], v0[1]); w.y = cvt_pk_bf16(v0[2], v0[3]); w.z = cvt_pk_bf16(v1[0], v1[1]); w.w = cvt_pk_bf16(v1[2], v1[3]);
                    *(u32x4*)(rowp + bj * HALF) = w; } }
    }
};
struct EpiResAdd {
    static constexpr bool PERM = false, AFTER_DRAIN = false, INIT = false, PREFETCH = false, MICRO = false;
    float* X; int ldc;
    __device__ __forceinline__ void operator()(const f32x4 (&acc)[2][2][4][2], const Unit& u, int wr, int wc, int fr, int fq) const {
        const int row0 = u.pm * BM + wr * 64 + fr; const int col0 = u.pn * BM + wc * 32 + 4 * fq;
#pragma unroll
        for (int ai = 0; ai < 2; ++ai)
#pragma unroll
            for (int m = 0; m < 4; ++m) { float* rowp = X + (size_t)(row0 + ai * HALF + m * 16) * ldc + col0;
                f32x4 old[2][2];
#pragma unroll
                for (int bj = 0; bj < 2; ++bj)
#pragma unroll
                    for (int n = 0; n < 2; ++n) old[bj][n] = *(const f32x4*)(rowp + bj * HALF + n * 16);
#pragma unroll
                for (int bj = 0; bj < 2; ++bj)
#pragma unroll
                    for (int n = 0; n < 2; ++n) *(f32x4*)(rowp + bj * HALF + n * 16) = old[bj][n] + acc[ai][bj][m][n]; }
    }
};

__device__ __forceinline__ float dpp_ror1(float x) { return __builtin_bit_cast(float, __builtin_amdgcn_update_dpp(0, __builtin_bit_cast(int, x), 0x121, 0xf, 0xf, true)); }
__device__ __forceinline__ float dpp_ror2(float x) { return __builtin_bit_cast(float, __builtin_amdgcn_update_dpp(0, __builtin_bit_cast(int, x), 0x122, 0xf, 0xf, true)); }
__device__ __forceinline__ void conv_dpp(f32x4& a, const f32x4 g, const f32x4 gp, const f32x4 w1, const f32x4 w0) {
    float a0 = a[0], a1 = a[1], a2 = a[2], a3 = a[3];
    asm("s_nop 1\n\t"
        "v_fmac_f32_dpp %0, %4, %12 row_shr:1 row_mask:0xf bank_mask:0xf\n\t"
        "v_fmac_f32_dpp %1, %5, %13 row_shr:1 row_mask:0xf bank_mask:0xf\n\t"
        "v_fmac_f32_dpp %2, %6, %14 row_shr:1 row_mask:0xf bank_mask:0xf\n\t"
        "v_fmac_f32_dpp %3, %7, %15 row_shr:1 row_mask:0xf bank_mask:0xf\n\t"
        "v_fmac_f32_dpp %0, %4, %16 row_shr:2 row_mask:0xf bank_mask:0xf\n\t"
        "v_fmac_f32_dpp %1, %5, %17 row_shr:2 row_mask:0xf bank_mask:0xf\n\t"
        "v_fmac_f32_dpp %2, %6, %18 row_shr:2 row_mask:0xf bank_mask:0xf\n\t"
        "v_fmac_f32_dpp %3, %7, %19 row_shr:2 row_mask:0xf bank_mask:0xf\n\t"
        "v_fmac_f32_dpp %0, %8, %12 row_shl:15 row_mask:0xf bank_mask:0xf\n\t"
        "v_fmac_f32_dpp %1, %9, %13 row_shl:15 row_mask:0xf bank_mask:0xf\n\t"
        "v_fmac_f32_dpp %2, %10, %14 row_shl:15 row_mask:0xf bank_mask:0xf\n\t"
        "v_fmac_f32_dpp %3, %11, %15 row_shl:15 row_mask:0xf bank_mask:0xf\n\t"
        "v_fmac_f32_dpp %0, %8, %16 row_shl:14 row_mask:0xf bank_mask:0xf\n\t"
        "v_fmac_f32_dpp %1, %9, %17 row_shl:14 row_mask:0xf bank_mask:0xf\n\t"
        "v_fmac_f32_dpp %2, %10, %18 row_shl:14 row_mask:0xf bank_mask:0xf\n\t"
        "v_fmac_f32_dpp %3, %11, %19 row_shl:14 row_mask:0xf bank_mask:0xf"
        : "+v"(a0), "+v"(a1), "+v"(a2), "+v"(a3)
        : "v"(g[0]), "v"(g[1]), "v"(g[2]), "v"(g[3]), "v"(gp[0]), "v"(gp[1]), "v"(gp[2]), "v"(gp[3]),
          "v"(w1[0]), "v"(w1[1]), "v"(w1[2]), "v"(w1[3]), "v"(w0[0]), "v"(w0[1]), "v"(w0[2]), "v"(w0[3]));
    a = (f32x4){a0, a1, a2, a3};
}
__device__ __forceinline__ float row_rstd(const float* ssq, int row) {
    const f32x4 a = *(const f32x4*)(ssq + (size_t)row * 16), b = *(const f32x4*)(ssq + (size_t)row * 16 + 4), c = *(const f32x4*)(ssq + (size_t)row * 16 + 8), d = *(const f32x4*)(ssq + (size_t)row * 16 + 12);
    const float s = ((a[0] + a[1]) + (a[2] + a[3])) + ((b[0] + b[1]) + (b[2] + b[3])) + ((c[0] + c[1]) + (c[2] + c[3])) + ((d[0] + d[1]) + (d[2] + d[3]));
    return rsqrtf(s * (1.0f / 1024.0f) + 1e-6f);
}
__device__ __forceinline__ void ssq_prefetch(const bf16_t* ssq, int pm, PG8_LAS unsigned char* blk) {
    int t = threadIdx.x; asm volatile("" : "+v"(t)); const int w = __builtin_amdgcn_readfirstlane(t >> 6);
    const bf16_t* src = ssq + (size_t)pm * BM * 32 + (size_t)t * 8;
    __builtin_amdgcn_global_load_lds((const unsigned*)src, (PG8_LAS unsigned*)(blk + w * 1024), 16, 0, 0);
    __builtin_amdgcn_global_load_lds((const unsigned*)(src + 4096), (PG8_LAS unsigned*)(blk + 8192 + w * 1024), 16, 0, 0);
}
__device__ __forceinline__ void rstd_table_fill(const PG8_LAS unsigned char* blk, PG8_LAS float* tab) {
    int t = threadIdx.x; asm volatile("" : "+v"(t)); const int row = t >> 1, hf = t & 1;
    const u32x4 a = *(const PG8_LAS u32x4*)(blk + row * 64 + 32 * hf), b = *(const PG8_LAS u32x4*)(blk + row * 64 + 32 * hf + 16);
    float s = 0.f;
#pragma unroll
    for (int e = 0; e < 4; ++e) { s += __uint_as_float(a[e] << 16) + __uint_as_float(a[e] & 0xffff0000u); s += __uint_as_float(b[e] << 16) + __uint_as_float(b[e] & 0xffff0000u); }
    s += __shfl_xor(s, 1);
    if (hf == 0) tab[row] = rsqrtf(s * (1.0f / 1024.0f) + 1e-6f);
}
struct EpiBf16CX {
    static constexpr bool PERM = true, AFTER_DRAIN = false, INIT = false, PREFETCH = true, MICRO = false;
    static constexpr int LDC = 2048;
    bf16_t* O; const bf16_t* ssq; PG8_LAS float* tab; PG8_LAS unsigned char* blk;
    __device__ __forceinline__ void prefetch(const Unit& u) const { ssq_prefetch(ssq, u.pm, blk); }
    __device__ __forceinline__ void operator()(const f32x4 (&acc)[2][2][4][2], const Unit& u, int wr, int wc, int fr, int fq) const {
        rstd_table_fill(blk, tab);
        asm volatile("s_waitcnt lgkmcnt(0)" ::: "memory"); __builtin_amdgcn_s_barrier(); asm volatile("" ::: "memory");
        const int row0 = u.pm * BM + wr * 64 + fr;
        if (u.pn < 4) {
            const int col0 = u.pn * BM + wc * 32 + 8 * fq;
#pragma unroll
            for (int ai = 0; ai < 2; ++ai)
#pragma unroll
                for (int m = 0; m < 4; ++m) { const int row = row0 + ai * HALF + m * 16; const float rs = tab[ai * HALF + wr * 64 + m * 16 + fr]; bf16_t* rowp = O + (size_t)row * LDC + col0;
#pragma unroll
                    for (int bj = 0; bj < 2; ++bj) { const f32x4 v0 = acc[ai][bj][m][0] * rs, v1 = acc[ai][bj][m][1] * rs;
                        u32x4 w; w.x = cvt_pk_bf16(v0[0], v0[1]); w.y = cvt_pk_bf16(v0[2], v0[3]); w.z = cvt_pk_bf16(v1[0], v1[1]); w.w = cvt_pk_bf16(v1[2], v1[3]);
                        *(u32x4*)(rowp + bj * HALF) = w; } }
        } else {
            const int col0 = 1024 + (u.pn - 4) * HALF + wc * 32 + 8 * fq;
#pragma unroll
            for (int ai = 0; ai < 2; ++ai)
#pragma unroll
                for (int m = 0; m < 4; ++m) { const int row = row0 + ai * HALF + m * 16; const float rs = tab[ai * HALF + wr * 64 + m * 16 + fr]; const float r2 = rs * rs;
                    const f32x4 v0 = acc[ai][0][m][0] * acc[ai][1][m][0] * r2, v1 = acc[ai][0][m][1] * acc[ai][1][m][1] * r2;
                    u32x4 w; w.x = cvt_pk_bf16(v0[0], v0[1]); w.y = cvt_pk_bf16(v0[2], v0[3]); w.z = cvt_pk_bf16(v1[0], v1[1]); w.w = cvt_pk_bf16(v1[2], v1[3]);
                    *(u32x4*)(O + (size_t)row * LDC + col0) = w; }
        }
    }
};
struct EpiBf16N {
    static constexpr bool PERM = true, AFTER_DRAIN = false, INIT = false, PREFETCH = true, MICRO = false;
    bf16_t* O; int ldc; const bf16_t* ssq; PG8_LAS float* tab; PG8_LAS unsigned char* blk;
    const float* znw; int zpn;
    __device__ __forceinline__ void prefetch(const Unit& u) const { ssq_prefetch(ssq, u.pm, blk); }
    __device__ __forceinline__ void operator()(const f32x4 (&acc)[2][2][4][2], const Unit& u, int wr, int wc, int fr, int fq) const {
        if ((u.pn == zpn) || (u.pn == zpn + 1)) run<true>(acc, u, wr, wc, fr, fq); else run<false>(acc, u, wr, wc, fr, fq); }
    template <bool zt>
    __device__ __forceinline__ void run(const f32x4 (&acc)[2][2][4][2], const Unit& u, int wr, int wc, int fr, int fq) const {
        f32x4 nw0 = {1.f, 1.f, 1.f, 1.f}, nw1 = nw0;
        if constexpr (zt) { nw0 = *(const f32x4*)(znw + wc * 32 + 8 * fq); nw1 = *(const f32x4*)(znw + wc * 32 + 8 * fq + 4); }
        rstd_table_fill(blk, tab);
        asm volatile("s_waitcnt lgkmcnt(0)" ::: "memory"); __builtin_amdgcn_s_barrier(); asm volatile("" ::: "memory");
        const int row0 = u.pm * BM + wr * 64 + fr; const int col0 = u.pn * BM + wc * 32 + 8 * fq;
#pragma unroll
        for (int ai = 0; ai < 2; ++ai)
#pragma unroll
            for (int m = 0; m < 4; ++m) { const int row = row0 + ai * HALF + m * 16; const float rs = tab[ai * HALF + wr * 64 + m * 16 + fr]; bf16_t* rowp = O + (size_t)row * ldc + col0;
#pragma unroll
                for (int bj = 0; bj < 2; ++bj) { f32x4 v0 = acc[ai][bj][m][0] * rs, v1 = acc[ai][bj][m][1] * rs;
                    if constexpr (zt) {
#pragma unroll
                        for (int j = 0; j < 4; ++j) { v0[j] = v0[j] * __builtin_amdgcn_rcpf(1.f + __builtin_amdgcn_exp2f(-1.4426950408889634f * v0[j])); v1[j] = v1[j] * __builtin_amdgcn_rcpf(1.f + __builtin_amdgcn_exp2f(-1.4426950408889634f * v1[j])); }
                        v0 = v0 * nw0; v1 = v1 * nw1; }
                    u32x4 w; w.x = cvt_pk_bf16(v0[0], v0[1]); w.y = cvt_pk_bf16(v0[2], v0[3]); w.z = cvt_pk_bf16(v1[0], v1[1]); w.w = cvt_pk_bf16(v1[2], v1[3]);
                    *(u32x4*)(rowp + bj * HALF) = w; } }
    }
};
struct EpiResNorm {
    static constexpr bool PERM = true, AFTER_DRAIN = false, INIT = true, PREFETCH = false, MICRO = true;
    bf16_t* XB; bf16_t* SSQ; PG8_LAS float* rsx;
    static __device__ __forceinline__ int xslot(int s_) { return 131072 + 1024 + s_ * 8192; }
    __device__ __forceinline__ void micro_epilogue(const f32x4 (&as)[2], const Unit& u, int wr, int wc, int fr, int fq) const {
        asm volatile("" : "+v"(fr), "+v"(fq));
        const int bjs = u.pm >> 5, row = 16384 + 32 * (u.pm & 31) + 16 * wr + fr;
        bf16_t* p = XB + (size_t)row * 1024 + u.pn * BM + bjs * HALF + wc * 32 + 8 * fq;
        const u32x4 o = *(const u32x4*)p;
        const float t0 = __uint_as_float(o.x << 16) + as[0][0], t1 = __uint_as_float(o.x & 0xffff0000u) + as[0][1], t2 = __uint_as_float(o.y << 16) + as[0][2], t3 = __uint_as_float(o.y & 0xffff0000u) + as[0][3];
        const float t4 = __uint_as_float(o.z << 16) + as[1][0], t5 = __uint_as_float(o.z & 0xffff0000u) + as[1][1], t6 = __uint_as_float(o.w << 16) + as[1][2], t7 = __uint_as_float(o.w & 0xffff0000u) + as[1][3];
        float sq = ((t0 * t0 + t1 * t1) + (t2 * t2 + t3 * t3)) + ((t4 * t4 + t5 * t5) + (t6 * t6 + t7 * t7));
        u32x4 w; w.x = cvt_pk_bf16(t0, t1); w.y = cvt_pk_bf16(t2, t3); w.z = cvt_pk_bf16(t4, t5); w.w = cvt_pk_bf16(t6, t7); *(u32x4*)p = w;
        sq += __shfl_xor(sq, 16); sq += __shfl_xor(sq, 32);
        if (fq == 0) rsx[(wr * 16 + fr) * 4 + wc] = sq;
        asm volatile("s_waitcnt lgkmcnt(0)" ::: "memory"); __builtin_amdgcn_s_barrier(); asm volatile("" ::: "memory");
        if (wc == 0 && fq == 0) { const f32x4 q4 = *(const PG8_LAS f32x4*)(rsx + (wr * 16 + fr) * 4);
            *(unsigned long long*)(SSQ + (size_t)row * 32 + 8 * u.pn + 4 * bjs) = (unsigned long long)cvt_pk_bf16((q4[0] + q4[1]) + (q4[2] + q4[3]), 0.f); }
    }
    __device__ __forceinline__ void init(f32x4 (&acc)[2][2][4][2], const Unit& u, int wr, int wc, int fr, int fq) const {
        const int row0 = u.pm * BM + wr * 64 + fr; const int col0 = u.pn * BM + wc * 32 + 8 * fq;
#pragma unroll
        for (int ai = 0; ai < 2; ++ai)
#pragma unroll
            for (int m = 0; m < 4; ++m)
#pragma unroll
                for (int bj = 0; bj < 2; ++bj) { const u32x4 o = *(const u32x4*)(XB + (size_t)(row0 + ai * HALF + m * 16) * 1024 + col0 + bj * HALF);
                    acc[ai][bj][m][0] = (f32x4){__uint_as_float(o.x << 16), __uint_as_float(o.x & 0xffff0000u), __uint_as_float(o.y << 16), __uint_as_float(o.y & 0xffff0000u)};
                    acc[ai][bj][m][1] = (f32x4){__uint_as_float(o.z << 16), __uint_as_float(o.z & 0xffff0000u), __uint_as_float(o.w << 16), __uint_as_float(o.w & 0xffff0000u)}; }
    }
    __device__ __forceinline__ void operator()(const f32x4 (&acc)[2][2][4][2], const Unit& u, int wr, int wc, int fr, int fq) const {
        asm volatile("" : "+v"(fr), "+v"(fq));
        const int row0 = u.pm * BM + wr * 64 + fr; const int col0 = u.pn * BM + wc * 32 + 8 * fq;
#pragma unroll
        for (int ai = 0; ai < 2; ++ai)
#pragma unroll
            for (int m = 0; m < 4; ++m) { const int row = row0 + ai * HALF + m * 16; bf16_t* rowb = XB + (size_t)row * 1024 + col0;
                float s[2];
#pragma unroll
                for (int bj = 0; bj < 2; ++bj) { const f32x4 a0 = acc[ai][bj][m][0], a1 = acc[ai][bj][m][1];
                    s[bj] = ((a0[0] * a0[0] + a0[1] * a0[1]) + (a0[2] * a0[2] + a0[3] * a0[3])) + ((a1[0] * a1[0] + a1[1] * a1[1]) + (a1[2] * a1[2] + a1[3] * a1[3]));
                    u32x4 w; w.x = cvt_pk_bf16(a0[0], a0[1]); w.y = cvt_pk_bf16(a0[2], a0[3]); w.z = cvt_pk_bf16(a1[0], a1[1]); w.w = cvt_pk_bf16(a1[2], a1[3]); *(u32x4*)(rowb + bj * HALF) = w; }
#pragma unroll
                for (int bj = 0; bj < 2; ++bj) { s[bj] += __shfl_xor(s[bj], 16); s[bj] += __shfl_xor(s[bj], 32); }
                if (fq == 0) { SSQ[(size_t)row * 32 + 8 * u.pn + wc] = (bf16_t)(cvt_pk_bf16(s[0], 0.f) & 0xffffu); SSQ[(size_t)row * 32 + 8 * u.pn + 4 + wc] = (bf16_t)(cvt_pk_bf16(s[1], 0.f) & 0xffffu); } }
    }
};
struct EpiUpAct {
    static constexpr bool PERM = true, AFTER_DRAIN = false, INIT = false, PREFETCH = true, MICRO = false;
    bf16_t* ACT; const bf16_t* ssq; const float* cw; const float* st; float* fc_p; float* fc_s; float* FIX; float* HALO; PG8_LAS float* hx; PG8_LAS float* tab; PG8_LAS unsigned char* blk;
    __device__ __forceinline__ void prefetch(const Unit& u) const { ssq_prefetch(ssq, u.pm, blk); }
    __device__ __forceinline__ void operator()(f32x4 (&acc)[2][2][4][2], const Unit& u, int wr, int wc, int fr, int fq) const {
        if (u.pm >= 64) run<true>(acc, u, wr, wc, fr, fq); else run<false>(acc, u, wr, wc, fr, fq); }
    template <bool sample>
    __device__ __forceinline__ void run(f32x4 (&acc)[2][2][4][2], const Unit& u, int wr, int wc, int fr, int fq) const {
        constexpr int FF = 2816;
        asm volatile("" : "+v"(fr), "+v"(fq));
        const int pmod = u.pm & 7;
        const int L0 = 128 * u.pn + 32 * wc + 8 * fq;
        f32x4 w0[2], w1[2], w2[2];
#pragma unroll
        for (int n = 0; n < 2; ++n) { w0[n] = *(const f32x4*)(cw + L0 + 4 * n); w1[n] = *(const f32x4*)(cw + FF + L0 + 4 * n); w2[n] = *(const f32x4*)(cw + 2 * FF + L0 + 4 * n); }
        rstd_table_fill(blk, tab);
        if (fr >= 14) {
#pragma unroll
            for (int ai = 0; ai < 2; ++ai)
#pragma unroll
                for (int n = 0; n < 2; ++n) *(PG8_LAS f32x4*)(hx + ((((ai * 2 + wr) * 4 + wc) * 2 + (fr - 14)) * 32 + fq * 8 + n * 4)) = acc[ai][0][3][n];
        }
        asm volatile("s_waitcnt lgkmcnt(0)" ::: "memory"); __builtin_amdgcn_s_barrier(); asm volatile("" ::: "memory");
        const int tau = fr & 7;
        f32x4 c1[2], c2[2];
        auto ldstate = [&](int ai_, int m_, f32x4 (&q1)[2], f32x4 (&q2)[2]) {
            const int s = (u.pm * BM + ai_ * HALF + wr * 64 + m_ * 16 + fr - 16384) >> 3; const float* sp = st + (size_t)s * 2 * FF + L0;
#pragma unroll
            for (int n = 0; n < 2; ++n) { q1[n] = *(const f32x4*)(sp + FF + 4 * n); q2[n] = *(const f32x4*)(sp + 4 * n); } };
        if constexpr (sample) ldstate(0, 0, c1, c2);
#pragma unroll
        for (int ai = 0; ai < 2; ++ai) {
            float rs[4];
#pragma unroll
            for (int m = 0; m < 4; ++m) rs[m] = tab[ai * HALF + wr * 64 + m * 16 + fr];
            f32x4 gp[2] = {{0.f, 0.f, 0.f, 0.f}, {0.f, 0.f, 0.f, 0.f}};
            if (!(ai == 0 && wr == 0)) { const int as = wr == 1 ? ai : 0, ws = wr == 1 ? 0 : 1;
                const PG8_LAS float* hp = hx + (((as * 2 + ws) * 4 + wc) * 2) * 32 + fq * 8;
                const int rb = as * HALF + ws * 64 + 48;
                if (fr >= 14) { const float sc = tab[rb + fr]; gp[0] = *(const PG8_LAS f32x4*)(hp + (fr - 14) * 32) * sc; gp[1] = *(const PG8_LAS f32x4*)(hp + (fr - 14) * 32 + 4) * sc; } }
#pragma unroll
            for (int m = 0; m < 4; ++m) {
                const int rt = ai * HALF + wr * 64 + m * 16 + fr, row = u.pm * BM + rt;
                f32x4 n1[2], n2[2];
                if constexpr (sample) { if (!(ai == 1 && m == 3)) ldstate(m == 3 ? ai + 1 : ai, m == 3 ? 0 : m + 1, n1, n2); }
                u32x4 ow;
#pragma unroll
                for (int n = 0; n < 2; ++n) {
                    const int L = L0 + 4 * n;
                    const f32x4 g = acc[ai][0][m][n] * rs[m], v = acc[ai][1][m][n] * rs[m];
                    f32x4 a;
                    if constexpr (sample) {
                        f32x4 p1, p2;
#pragma unroll
                        for (int j = 0; j < 4; ++j) { const float h1 = fr == 15 ? gp[n][j] : g[j], h2 = fr >= 14 ? gp[n][j] : g[j]; p1[j] = dpp_ror1(h1); p2[j] = dpp_ror2(h2); }
                        const int s = (row - 16384) >> 3;
#pragma unroll
                        for (int j = 0; j < 4; ++j) { p2[j] = tau == 0 ? c2[n][j] : (tau == 1 ? c1[n][j] : p2[j]); p1[j] = tau == 0 ? c1[n][j] : p1[j]; }
                        if (tau >= 6) *(f32x4*)(fc_s + ((size_t)s * 2 + (tau - 6)) * FF + L) = g;
                        a = w0[n] * p2 + w1[n] * p1 + w2[n] * g;
                    } else {
                        if (ai == 0 && m == 0) { if (rt < 2 && pmod != 0) { float* fx = FIX + ((size_t)(u.pm * 2 + rt) * 2) * FF + L; *(f32x4*)fx = g; *(f32x4*)(fx + FF) = v; } }
                        if (ai == 1 && m == 3) { if (rt >= 254) { if (pmod != 7) *(f32x4*)(HALO + ((size_t)u.pm * 2 + (rt - 254)) * FF + L) = g;
                                                                  else *(f32x4*)(fc_p + ((size_t)(u.pm >> 3) * 2 + (rt - 254)) * FF + L) = g; } }
                        a = w2[n] * g; conv_dpp(a, g, gp[n], w1[n], w0[n]);
                    }
                    const f32x4 t = a * (f32x4){-1.4426950408889634f, -1.4426950408889634f, -1.4426950408889634f, -1.4426950408889634f};
                    f32x4 d = {__builtin_amdgcn_exp2f(t[0]), __builtin_amdgcn_exp2f(t[1]), __builtin_amdgcn_exp2f(t[2]), __builtin_amdgcn_exp2f(t[3])};
                    d = d + (f32x4){1.f, 1.f, 1.f, 1.f};
                    const f32x4 r = {__builtin_amdgcn_rcpf(d[0]), __builtin_amdgcn_rcpf(d[1]), __builtin_amdgcn_rcpf(d[2]), __builtin_amdgcn_rcpf(d[3])};
                    const f32x4 o = a * r * v;
                    if (n == 0) { ow.x = cvt_pk_bf16(o[0], o[1]); ow.y = cvt_pk_bf16(o[2], o[3]); } else { ow.z = cvt_pk_bf16(o[0], o[1]); ow.w = cvt_pk_bf16(o[2], o[3]); }
                    gp[n] = g;
                }
                *(u32x4*)(ACT + (size_t)row * FF + L0) = ow;
                asm volatile("" ::: "memory");
                if constexpr (sample) { if (!(ai == 1 && m == 3)) {
#pragma unroll
                    for (int n = 0; n < 2; ++n) { c1[n] = n1[n]; c2[n] = n2[n]; } } }
            }
        }
    }
};

template <class Epi, class Sched, bool ALIGN_EPI = false, bool SP2 = false>
__device__ __forceinline__ void gemm_phase(PG8_LAS unsigned char* lds, const Gemm g, const Sched& S, const Epi& E) {
    int tid = threadIdx.x; asm volatile("" : "+v"(tid));
    const int wid = __builtin_amdgcn_readfirstlane(tid >> 6), lane = tid & 63, wr = wid >> 2, wc = wid & 3, fr = lane & 15, fq = lane >> 4;
    const int K = g.K, nt = K / BK;
    unsigned voffA[2], voffB[2];
#pragma unroll
    for (int i = 0; i < 2; ++i) { int R, C; stage_rc(tid * 16 + i * 8192, R, C); const int Rb = Epi::PERM ? ((R & ~31) + perm32(R & 31)) : R;
        voffA[i] = (unsigned)(R * K + C) * 2u; voffB[i] = (unsigned)(Rb * K + C) * 2u; }
    const size_t kstep = (size_t)(BK * 2);
    const size_t hstep = (size_t)HALF * K * 2;
    const size_t tstep = 2 * hstep;
    const unsigned ldsw = (unsigned)wid * 1024u;
    const int aoff = lds_byte(wr * 64 + fr, fq * 8), boff = lds_byte(wc * 32 + fr, fq * 8);
#define PG8_SA(b, h) (((b) * 2 + (h)) * HTB)
#define PG8_SB(b, h) ((4 + (b) * 2 + (h)) * HTB)
#define PG8_STAGE(bufoff, gbase, voff) do { _Pragma("unroll") for (int _i = 0; _i < 2; ++_i) \
        __builtin_amdgcn_global_load_lds((const unsigned*)((const char*)(gbase) + (voff)[_i]), (PG8_LAS unsigned*)(lds + (bufoff) + ldsw + _i * 8192), 16, 0, 0); } while (0)
#define PG8_LDA(dst, b, h) do { _Pragma("unroll") for (int m = 0; m < 4; ++m) _Pragma("unroll") for (int k = 0; k < 2; ++k) dst[m][k] = *(const PG8_LAS bf16x8*)(lds + PG8_SA(b, h) + aoff + m * 2048 + k * 1024); } while (0)
#define PG8_LDB(dst, b, h) do { _Pragma("unroll") for (int n = 0; n < 2; ++n) _Pragma("unroll") for (int k = 0; k < 2; ++k) dst[n][k] = *(const PG8_LAS bf16x8*)(lds + PG8_SB(b, h) + boff + n * 2048 + k * 1024); } while (0)
#define PG8_MMA(ai, bj, At, Bt) do { __builtin_amdgcn_s_setprio(1); _Pragma("unroll") for (int m = 0; m < 4; ++m) _Pragma("unroll") for (int n = 0; n < 2; ++n) _Pragma("unroll") for (int k = 0; k < 2; ++k) \
        acc[ai][bj][m][n] = __builtin_amdgcn_mfma_f32_16x16x32_bf16(Bt[n][k], At[m][k], acc[ai][bj][m][n], 0, 0, 0); __builtin_amdgcn_s_setprio(0); } while (0)
#define PG8_WAIT_V(n) asm volatile("s_waitcnt vmcnt(" #n ")" ::: "memory")
#define PG8_WAIT_L(n) asm volatile("s_waitcnt lgkmcnt(" #n ")" ::: "memory")
#define PG8_BAR __builtin_amdgcn_s_barrier()
#define PG8_SCHED __builtin_amdgcn_sched_barrier(0)
    Unit cur, nxt; int ui = 0;
    if (!S.next(0, cur)) return;
    f32x4 acc[2][2][4][2];
    if constexpr (Epi::PREFETCH) E.prefetch(cur);
    if constexpr (Epi::INIT) E.init(acc, cur, wr, wc, fr, fq);
    else {
#pragma unroll
    for (int a = 0; a < 2; ++a)
#pragma unroll
        for (int b = 0; b < 2; ++b)
#pragma unroll
            for (int m = 0; m < 4; ++m)
#pragma unroll
                for (int n = 0; n < 2; ++n) acc[a][b][m][n] = (f32x4){0.f, 0.f, 0.f, 0.f};
    }
    bf16x8 At[4][2], B0[2][2], B1[2][2];
    f32x4 acc_s[2]; int mq = 0, xb = 0; unsigned xso = 0u, xro0 = 0u;
    PG8_LAS unsigned char* const xbase = lds + 131072 + 1024;
#define PG8_MICRO_STAGE(kt) do { __builtin_amdgcn_global_load_lds((const unsigned*)((const char*)g.A + (size_t)(kt) * (BK * 2) + xso), (PG8_LAS unsigned*)(xbase + xb * 8192 + wid * 1024), 16, 0, 0); xb = xb == 2 ? 0 : xb + 1; } while (0)
#define PG8_MICRO_SETUP(u_) do { if constexpr (Epi::MICRO) { mq = (u_).pm >> 5; \
        { const int p_ = tid & 511, r_ = (p_ >> 3) & 31, s_ = p_ & 7; xso = (unsigned)((16384 + 32 * ((u_).pm & 31) + r_) * K + 8 * (s_ ^ (r_ & 7))) * 2u; } \
        xro0 = (unsigned)((16 * wr + fr) * 128 + ((fq ^ (fr & 7)) << 4));   \
        acc_s[0] = (f32x4){0.f, 0.f, 0.f, 0.f}; acc_s[1] = acc_s[0]; xb = 0; } } while (0)
#define PG8_MICRO_MMA1(Bf, slot) do { At[0][0] = *(const PG8_LAS bf16x8*)(xbase + (slot) * 8192 + xro0); At[0][1] = *(const PG8_LAS bf16x8*)(xbase + (slot) * 8192 + (xro0 ^ 64u)); \
        _Pragma("unroll") for (int n_ = 0; n_ < 2; ++n_) _Pragma("unroll") for (int k_ = 0; k_ < 2; ++k_) acc_s[n_] = __builtin_amdgcn_mfma_f32_16x16x32_bf16(Bf[n_][k_], At[0][k_], acc_s[n_], 0, 0, 0); } while (0)
#define PG8_MMA_SP2_MICRO(slot) do { __builtin_amdgcn_s_setprio(1); \
        _Pragma("unroll") for (int m = 0; m < 4; ++m) { \
            _Pragma("unroll") for (int n = 0; n < 2; ++n) _Pragma("unroll") for (int k = 0; k < 2; ++k) { \
                acc[1][0][m][n] = __builtin_amdgcn_mfma_f32_16x16x32_bf16(B0[n][k], At[m][k], acc[1][0][m][n], 0, 0, 0); \
                acc[1][1][m][n] = __builtin_amdgcn_mfma_f32_16x16x32_bf16(B1[n][k], At[m][k], acc[1][1][m][n], 0, 0, 0); } \
            if (m == 0) { At[0][0] = *(const PG8_LAS bf16x8*)(lds + Epi::xslot(slot) + xro0); At[0][1] = *(const PG8_LAS bf16x8*)(lds + Epi::xslot(slot) + (xro0 ^ 64u)); } } \
        if (mq == 0) { _Pragma("unroll") for (int n_ = 0; n_ < 2; ++n_) _Pragma("unroll") for (int k_ = 0; k_ < 2; ++k_) acc_s[n_] = __builtin_amdgcn_mfma_f32_16x16x32_bf16(B0[n_][k_], At[0][k_], acc_s[n_], 0, 0, 0); } \
        else { _Pragma("unroll") for (int n_ = 0; n_ < 2; ++n_) _Pragma("unroll") for (int k_ = 0; k_ < 2; ++k_) acc_s[n_] = __builtin_amdgcn_mfma_f32_16x16x32_bf16(B1[n_][k_], At[0][k_], acc_s[n_], 0, 0, 0); } \
        __builtin_amdgcn_s_setprio(0); } while (0)
#define PG8_MICRO_MMA(slot) do { if constexpr (Epi::MICRO) { if (mq == 0) PG8_MICRO_MMA1(B0, slot); else PG8_MICRO_MMA1(B1, slot); } } while (0)
#define PG8_WAIT_VM(n, nm) do { if constexpr (Epi::MICRO) PG8_WAIT_V(nm); else PG8_WAIT_V(n); } while (0)
    const char* cA = (const char*)g.A + (size_t)cur.pm * tstep; const char* cB = (const char*)g.Bt + (size_t)cur.pn * tstep;
    S.a_ready(cur);
    PG8_MICRO_SETUP(cur);
    int xrd = 0;
    if constexpr (Epi::MICRO) PG8_MICRO_STAGE(0);
    if constexpr (SP2) {
        PG8_STAGE(PG8_SB(0, 0), cB, voffB); PG8_STAGE(PG8_SB(0, 1), cB + hstep, voffB); PG8_STAGE(PG8_SA(0, 0), cA, voffA); PG8_STAGE(PG8_SA(0, 1), cA + hstep, voffA);
        if (wr == 1) PG8_BAR;
        PG8_WAIT_V(2); PG8_BAR;
        PG8_STAGE(PG8_SB(1, 0), cB + kstep, voffB); PG8_STAGE(PG8_SA(1, 0), cA + kstep, voffA); PG8_STAGE(PG8_SB(1, 1), cB + hstep + kstep, voffB);
        PG8_WAIT_V(6); PG8_BAR;
    } else {
        PG8_STAGE(PG8_SB(0, 0), cB, voffB); PG8_STAGE(PG8_SA(0, 0), cA, voffA); PG8_STAGE(PG8_SB(0, 1), cB + hstep, voffB); PG8_STAGE(PG8_SA(0, 1), cA + hstep, voffA);
        if (wr == 1) PG8_BAR;
        PG8_WAIT_V(4); PG8_BAR;
        PG8_STAGE(PG8_SB(1, 0), cB + kstep, voffB); PG8_STAGE(PG8_SA(1, 0), cA + kstep, voffA); PG8_STAGE(PG8_SB(1, 1), cB + hstep + kstep, voffB);
        PG8_WAIT_V(6); PG8_BAR;
    }
    for (;;) {
        const bool has_next = S.next(ui + 1, nxt);
        const char* nA = has_next ? (const char*)g.A + (size_t)nxt.pm * tstep : cA; const char* nB = has_next ? (const char*)g.Bt + (size_t)nxt.pn * tstep : cB;
        for (int t = 0; t < nt; t += 2) {
            const bool last = (t == nt - 2);
            const char* a1 = cA + (size_t)(t + 1) * kstep;
            const char* a2 = last ? nA : cA + (size_t)(t + 2) * kstep; const char* b2 = last ? nB : cB + (size_t)(t + 2) * kstep;
            const char* a3 = a2 + kstep; const char* b3 = b2 + kstep;
            if (last && has_next) S.a_ready(nxt);
            if constexpr (SP2) {
            PG8_LDB(B0, 0, 0); PG8_LDB(B1, 0, 1); PG8_SCHED; PG8_LDA(At, 0, 0); PG8_STAGE(PG8_SA(1, 1), a1 + hstep, voffA);
            if constexpr (Epi::MICRO) PG8_MICRO_STAGE(t + 1);
            PG8_WAIT_VM(8, 9); PG8_WAIT_L(0); PG8_BAR; PG8_MMA(0, 0, At, B0); PG8_MMA(0, 1, At, B1); PG8_BAR; PG8_SCHED;
            PG8_LDA(At, 0, 1); PG8_STAGE(PG8_SB(0, 0), b2, voffB); PG8_STAGE(PG8_SB(0, 1), b2 + hstep, voffB); PG8_STAGE(PG8_SA(0, 0), a2, voffA);
            PG8_WAIT_VM(8, 9); PG8_WAIT_L(0); PG8_BAR;
            if constexpr (Epi::MICRO) { PG8_MMA_SP2_MICRO(xrd); xrd = xrd == 2 ? 0 : xrd + 1; }
            else { PG8_MMA(1, 0, At, B0); PG8_MMA(1, 1, At, B1); }
            PG8_BAR; PG8_SCHED;
            PG8_LDB(B0, 1, 0); PG8_LDB(B1, 1, 1); PG8_SCHED; PG8_LDA(At, 1, 0); PG8_STAGE(PG8_SA(0, 1), a2 + hstep, voffA);
            if constexpr (Epi::MICRO) PG8_MICRO_STAGE(t + 2 < nt ? t + 2 : t + 1);
            PG8_WAIT_VM(8, 9); PG8_WAIT_L(0); PG8_BAR; PG8_MMA(0, 0, At, B0); PG8_MMA(0, 1, At, B1); PG8_BAR; PG8_SCHED;
            PG8_LDA(At, 1, 1); PG8_STAGE(PG8_SB(1, 0), b3, voffB); PG8_STAGE(PG8_SB(1, 1), b3 + hstep, voffB); PG8_STAGE(PG8_SA(1, 0), a3, voffA);
            PG8_WAIT_VM(8, 9); PG8_WAIT_L(0); PG8_BAR;
            if constexpr (Epi::MICRO) { PG8_MMA_SP2_MICRO(xrd); xrd = xrd == 2 ? 0 : xrd + 1; }
            else { PG8_MMA(1, 0, At, B0); PG8_MMA(1, 1, At, B1); }
            PG8_BAR; PG8_SCHED;
            } else {
            PG8_LDB(B0, 0, 0); PG8_SCHED; PG8_LDA(At, 0, 0); PG8_STAGE(PG8_SA(1, 1), a1 + hstep, voffA);
            PG8_WAIT_L(8); PG8_BAR; PG8_WAIT_L(0); PG8_MMA(0, 0, At, B0); PG8_BAR; PG8_SCHED;
            PG8_LDB(B1, 0, 1); PG8_STAGE(PG8_SB(0, 0), b2, voffB);
            PG8_BAR; PG8_WAIT_L(0); PG8_MMA(0, 1, At, B1); PG8_BAR;
            PG8_LDA(At, 0, 1); PG8_STAGE(PG8_SA(0, 0), a2, voffA);
            PG8_BAR; PG8_WAIT_L(0); PG8_MMA(1, 0, At, B0); PG8_BAR; PG8_SCHED;
            PG8_STAGE(PG8_SB(0, 1), b2 + hstep, voffB);
            PG8_WAIT_V(6); PG8_BAR; PG8_MMA(1, 1, At, B1); PG8_BAR;
            PG8_LDB(B0, 1, 0); PG8_SCHED; PG8_LDA(At, 1, 0); PG8_STAGE(PG8_SA(0, 1), a2 + hstep, voffA);
            PG8_WAIT_L(8); PG8_BAR; PG8_WAIT_L(0); PG8_MMA(0, 0, At, B0); PG8_BAR; PG8_SCHED;
            PG8_LDB(B1, 1, 1); PG8_STAGE(PG8_SB(1, 0), b3, voffB);
            PG8_BAR; PG8_WAIT_L(0); PG8_MMA(0, 1, At, B1); PG8_BAR;
            PG8_LDA(At, 1, 1); PG8_STAGE(PG8_SA(1, 0), a3, voffA);
            PG8_BAR; PG8_WAIT_L(0); PG8_MMA(1, 0, At, B0); PG8_BAR; PG8_SCHED;
            PG8_STAGE(PG8_SB(1, 1), b3 + hstep, voffB);
            PG8_WAIT_V(6); PG8_BAR; PG8_MMA(1, 1, At, B1); PG8_BAR;
            }
        }
        if constexpr (ALIGN_EPI) { if (wr == 0) PG8_BAR; }
        if constexpr (Epi::MICRO) E.micro_epilogue(acc_s, cur, wr, wc, fr, fq);
        if constexpr (!Epi::AFTER_DRAIN) { E(acc, cur, wr, wc, fr, fq); S.done(cur); }
        if (!has_next) break;
        if constexpr (Epi::PREFETCH) E.prefetch(nxt);
        if constexpr (Epi::INIT) E.init(acc, nxt, wr, wc, fr, fq);
        else {
#pragma unroll
        for (int a = 0; a < 2; ++a)
#pragma unroll
            for (int b = 0; b < 2; ++b)
#pragma unroll
                for (int m = 0; m < 4; ++m)
#pragma unroll
                    for (int n = 0; n < 2; ++n) acc[a][b][m][n] = (f32x4){0.f, 0.f, 0.f, 0.f};
        }
        cur = nxt; cA = nA; cB = nB; ++ui;
        if constexpr (ALIGN_EPI) { if (wr == 1) PG8_BAR; }
    }
    PG8_WAIT_V(0);
    if constexpr (!ALIGN_EPI) { if (wr == 0) PG8_BAR; }
    PG8_BAR;
    if constexpr (Epi::AFTER_DRAIN) { E.fused(acc, cur, wr, wc, fr, fq, lds, wid, lane); S.done(cur); }
#undef PG8_MICRO_SETUP
#undef PG8_MICRO_STAGE
#undef PG8_MICRO_MMA1
#undef PG8_MMA_SP2_MICRO
#undef PG8_MICRO_MMA
#undef PG8_WAIT_VM
#undef PG8_SA
#undef PG8_SB
#undef PG8_STAGE
#undef PG8_LDA
#undef PG8_LDB
#undef PG8_MMA
#undef PG8_WAIT_V
#undef PG8_WAIT_L
#undef PG8_BAR
#undef PG8_SCHED
}
}

constexpr int NTHREADS = 512, NWAVES = 8;
constexpr int D = 1024, MP = 16384, MS = 1024, M = MP + MS, SEQ = 2048, NB = 8, NS = 128, TS = 8;
constexpr int NAB = 2568, NABP = 2816, DFF = 2816, NUP = 5632, NCC = 3072, NH = 4;
constexpr float EPS = 1e-6f;
constexpr size_t O_Y = 0, O_POOL_P = 17825792, O_POOL_S = 17948672, O_DNC_P = 19914752, O_DNC_S = 19988480, O_DN_P = 21168128, O_DN_S = 22216704,
                 O_SC_P = 38993920, O_SC_S = 39026688, O_FC_P = 39550976, O_FC_S = 39731200;
constexpr size_t MiB = 1u << 20;
constexpr size_t CTL_ZERO_BYTES = 1 * MiB;
constexpr size_t WS_WINAB = 1 * MiB;
constexpr size_t WS_WOUTAB = WS_WINAB + (size_t)2 * NABP * D * 2;
constexpr size_t WS_WINC = WS_WOUTAB + (size_t)2 * D * D * 2;
constexpr size_t WS_WOUTC = WS_WINC + (size_t)2 * NCC * D * 2;
constexpr size_t WS_WUP = WS_WOUTC + (size_t)2 * D * D * 2;
constexpr size_t WS_WDOWN = WS_WUP + (size_t)4 * NUP * D * 2;
constexpr size_t WS_POOLW = WS_WDOWN + (size_t)4 * D * DFF * 2;
constexpr size_t WS_H = WS_POOLW + (size_t)2 * 4 * 128 * 128 * 2;
constexpr size_t WS_XB = WS_H + (size_t)M * D * 2;
constexpr size_t WS_SSQ = WS_XB + (size_t)M * D * 2;
constexpr size_t WS_FIX = WS_SSQ + (size_t)M * 32 * 4;
constexpr size_t WS_HALO = WS_FIX + (size_t)68 * 2 * 2 * DFF * 4;
constexpr size_t WS_RAW = WS_HALO + (size_t)68 * 2 * DFF * 4;
constexpr size_t WS_REC = WS_RAW + (size_t)M * NABP * 2;
constexpr size_t WS_ACT = WS_RAW;
constexpr size_t WS_END = WS_REC + (size_t)1024 * 73984;
static_assert(WS_END >= WS_RAW + (size_t)M * NCC * 2, "pool holds the C-layer projection");
constexpr int REC_NEGW = 0, REC_QG = 16384, REC_AQK = 32768, REC_KDT = 40960, REC_U = 57344, REC_GE = 73728, RECSZ = 73984, REC_STAGE = 57344;
constexpr int CW_BAR = 4096;
constexpr int LDS_BYTES = 163840, LDSCTL_OFF = 163328;

typedef unsigned short bf16;
typedef unsigned v4u __attribute__((ext_vector_type(4)));
typedef unsigned v2u __attribute__((ext_vector_type(2)));
typedef float f32x4 __attribute__((ext_vector_type(4)));
typedef short bf16x8 __attribute__((ext_vector_type(8)));
#define LDS_WAIT() asm volatile("s_waitcnt lgkmcnt(0)" ::: "memory")
DI unsigned pk2(float lo, float hi) { return pg8::cvt_pk_bf16(lo, hi); }
DI unsigned short f2bf(float x) { return __builtin_bit_cast(unsigned short, (__bf16)x); }
DI float bf2f(unsigned short b) { return __uint_as_float((unsigned)b << 16); }
DI float bflo(unsigned w) { return __uint_as_float(w << 16); }
DI float bfhi(unsigned w) { return __uint_as_float(w & 0xffff0000u); }
DI float siluf(float a) { return a * __builtin_amdgcn_rcpf(1.f + __expf(-a)); }
DI float sigmoidf_(float a) { return __builtin_amdgcn_rcpf(1.f + __expf(-a)); }
DI float softplusf_(float a) { return a > 15.f ? a : 0.6931471805599453f * __builtin_amdgcn_logf(1.f + __expf(a)); }
DI int fresh_tid() { int t = threadIdx.x; asm volatile("" : "+v"(t)); return t; }
DI float wave_sum(float v) {
#pragma unroll
    for (int o = 1; o < 64; o <<= 1) v += __shfl_xor(v, o);
    return v;
}
DI float transpose_reduce64_sq(const float (&q)[64], int lane) {
    float v[32];
    { const bool up = (lane & 32) != 0;
#pragma unroll
      for (int r = 0; r < 32; ++r) { const float a = q[r] * q[r], b = q[r + 32] * q[r + 32]; const float send = up ? a : b, keep = up ? b : a; v[r] = keep + __shfl_xor(send, 32); } }
#pragma unroll
    for (int m = 16; m >= 1; m >>= 1) {
        const bool up = (lane & m) != 0;
#pragma unroll
        for (int r = 0; r < m; ++r) {
            const float send = up ? v[r] : v[r + m];
            const float keep = up ? v[r + m] : v[r];
            v[r] = keep + __shfl_xor(send, m);
        }
    }
    return v[0];
}
DI bf16x8 pack8(const f32x4& a, const f32x4& b) { v4u w; w.x = pk2(a[0], a[1]); w.y = pk2(a[2], a[3]); w.z = pk2(b[0], b[1]); w.w = pk2(b[2], b[3]); return __builtin_bit_cast(bf16x8, w); }
#define MFMA16(a, b, c) __builtin_amdgcn_mfma_f32_16x16x32_bf16((a), (b), (c), 0, 0, 0)

struct Args { const float* in[24]; float* out; unsigned char* ws; int ph_lo, ph_hi; };
#define AS4 __attribute__((address_space(4)))
struct Frame {
    LAS unsigned char* lds;
    int tid, lane, wave, G, bid, z;
    unsigned char* ws; float* out;
    DI const float* in(int k) const { const char AS4* ka = (const char AS4*)__builtin_amdgcn_kernarg_segment_ptr(); return *(const float* const AS4*)(ka + 8 * k + z); }
    DI float* pX() const { return out + O_Y; }
    DI bf16* pWinab() const { return (bf16*)(ws + WS_WINAB); }
    DI bf16* pWoutab() const { return (bf16*)(ws + WS_WOUTAB); }
    DI bf16* pWinc() const { return (bf16*)(ws + WS_WINC); }
    DI bf16* pWoutc() const { return (bf16*)(ws + WS_WOUTC); }
    DI bf16* pWup() const { return (bf16*)(ws + WS_WUP); }
    DI bf16* pWdown() const { return (bf16*)(ws + WS_WDOWN); }
    DI bf16* pPoolW() const { return (bf16*)(ws + WS_POOLW); }
    DI bf16* pH() const { return (bf16*)(ws + WS_H); }
    DI bf16* pRAW() const { return (bf16*)(ws + WS_RAW); }
    DI bf16* pACT() const { return (bf16*)(ws + WS_ACT); }
    DI unsigned char* pREC() const { return ws + WS_REC; }
    DI bf16* pXB() const { return (bf16*)(ws + WS_XB); }
    DI bf16* pSSQ() const { return (bf16*)(ws + WS_SSQ); }
    DI float* pFIX() const { return (float*)(ws + WS_FIX); }
    DI float* pHALO() const { return (float*)(ws + WS_HALO); }
};

template <class RowMap>
DI void transpose_item(const float* W, int K, int N, bf16* WT, LAS float* scr, int item, int lane, RowMap rm, const float* kscale) {
    const int nblk = (N + 31) / 32, kb = item / nblk, nb = item % nblk, k0 = 64 * kb, n0 = 32 * nb;
    float ld_[32];
#pragma unroll
    for (int i = 0; i < 32; ++i) { const int kk = 2 * i + (lane >> 5); const int n = n0 + (lane & 31); ld_[i] = n < N ? W[(size_t)(k0 + kk) * N + n] : 0.f; }
#pragma unroll
    for (int i = 0; i < 32; ++i) { const int kk = 2 * i + (lane >> 5); const float sc = kscale ? kscale[k0 + kk] : 1.f; scr[kk * 33 + (lane & 31)] = ld_[i] * sc; }
    LDS_WAIT(); asm volatile("" ::: "memory");
    const int c = lane & 7;
#pragma unroll
    for (int j = 0; j < 4; ++j) { const int n = (lane >> 3) + 8 * j; const LAS float* s = scr + (8 * c) * 33 + n;
        v4u o; o.x = pk2(s[0 * 33], s[1 * 33]); o.y = pk2(s[2 * 33], s[3 * 33]); o.z = pk2(s[4 * 33], s[5 * 33]); o.w = pk2(s[6 * 33], s[7 * 33]);
        if (n0 + n < N) *(v4u*)(WT + (size_t)rm(n0 + n) * K + k0 + 8 * c) = o; }
    LDS_WAIT(); asm volatile("" ::: "memory");
}
struct RmId { DI int operator()(int n) const { return n; } };
struct RmInC {
    DI int operator()(int n) const { if (n < D) return n; const int isx = n >= 2 * D ? 1 : 0; const int c = n - D - isx * D; return D + (c >> 7) * 256 + isx * 128 + (c & 127); } };
struct RmUp {
    DI int operator()(int n) const { const int isv = n >= DFF ? 1 : 0; const int L = n - isv * DFF; return (L >> 7) * 256 + isv * 128 + (L & 127); } };

DI void convert_weights(const Args& A, Frame& F, int gw, int NGW, int part) {
    LAS float* scr = (LAS float*)(F.lds + F.wave * 16384);
    constexpr int I_INAB = (D / 64) * ((NAB + 31) / 32), I_SQ = (D / 64) * (D / 32), I_INC = (D / 64) * (NCC / 32), I_UP = (D / 64) * (NUP / 32), I_DOWN = (DFF / 64) * (D / 32), I_POOL = 2 * 4;
    const int total = part == 0 ? I_INAB + 8 * I_POOL : (part == 1 ? I_INAB + 2 * I_SQ + I_INC + 2 * I_UP + 2 * I_DOWN : 2 * I_SQ + I_INC + 2 * I_UP + 2 * I_DOWN);
    const int lb = part == 2 ? 1 : 0;
    for (int jt = gw; jt < total; jt += NGW) {
        int j = jt;
        if (part == 0) {
            if (j < I_INAB) { transpose_item(F.in(10), D, NAB, F.pWinab(), scr, j, F.lane, RmId(), F.in(7)); continue; }
            j -= I_INAB; { const int mtx = j / I_POOL, r = j % I_POOL; transpose_item(F.in(11) + (size_t)mtx * 128 * 128, 128, 128, F.pPoolW() + (size_t)mtx * 128 * 128, scr, r, F.lane, RmId(), nullptr); continue; }
        }
        if (part == 1) { if (j < I_INAB) { transpose_item(F.in(10) + (size_t)D * NAB, D, NAB, F.pWinab() + (size_t)NABP * D, scr, j, F.lane, RmId(), F.in(7) + (size_t)2 * D); continue; } j -= I_INAB; }
        if (j < I_SQ) { transpose_item(F.in(17) + (size_t)lb * D * D, D, D, F.pWoutab() + (size_t)lb * D * D, scr, j, F.lane, RmId(), nullptr); continue; } j -= I_SQ;
        if (j < I_INC) { transpose_item(F.in(18) + (size_t)lb * D * NCC, D, NCC, F.pWinc() + (size_t)lb * NCC * D, scr, j, F.lane, RmInC(), F.in(7) + (size_t)(2 * lb + 1) * D); continue; } j -= I_INC;
        if (j < I_SQ) { transpose_item(F.in(20) + (size_t)lb * D * D, D, D, F.pWoutc() + (size_t)lb * D * D, scr, j, F.lane, RmId(), nullptr); continue; } j -= I_SQ;
        if (j < 2 * I_UP) { const int l = 2 * lb + j / I_UP, r = j % I_UP; transpose_item(F.in(21) + (size_t)l * D * NUP, D, NUP, F.pWup() + (size_t)l * NUP * D, scr, r, F.lane, RmUp(), F.in(8) + (size_t)l * D); continue; } j -= 2 * I_UP;
        { const int l = 2 * lb + j / I_DOWN, r = j % I_DOWN; transpose_item(F.in(23) + (size_t)l * DFF * D, DFF, D, F.pWdown() + (size_t)l * D * DFF, scr, r, F.lane, RmId(), nullptr); }
    }
}
DI void p0_prologue(const Args& A, Frame& F) {
    convert_weights(A, F, F.bid * NWAVES + F.wave, F.G * NWAVES, 0);
    { const int gt = F.bid * NTHREADS + F.tid, NGT = F.G * NTHREADS; constexpr int PIECES = 2 * (NABP - NAB) * (D / 8);
      for (int p = gt; p < PIECES; p += NGT) { const int l = p / ((NABP - NAB) * (D / 8)), r = p % ((NABP - NAB) * (D / 8));
          const unsigned z_ = (unsigned)F.z;
          *(v4u*)(F.pWinab() + ((size_t)l * NABP + NAB) * D + (size_t)r * 8) = (v4u){z_, z_, z_, z_}; } }
}

DI void x0_phase(const Args& A, Frame& F) {
    const int gw = F.bid * NWAVES + F.wave, NGW = F.G * NWAVES;
    for (int m = gw; m < M; m += NGW) {
        const float* src = m < MP ? F.in(0) + (size_t)m * D : F.in(1) + (size_t)(m - MP) * D;
        const f32x4* xr = (const f32x4*)src + F.lane;
        f32x4 v[4]; float s = 0.f;
#pragma unroll
        for (int j = 0; j < 4; ++j) { v[j] = xr[64 * j]; s += (v[j].x * v[j].x + v[j].y * v[j].y) + (v[j].z * v[j].z + v[j].w * v[j].w); }
        s = wave_sum(s);
        v2u* o8 = (v2u*)(F.pXB() + (size_t)m * D) + F.lane;
#pragma unroll
        for (int j = 0; j < 4; ++j) { v2u o; o.x = pk2(v[j].x, v[j].y); o.y = pk2(v[j].z, v[j].w); o8[64 * j] = o; }
        if (F.lane < 32) F.pSSQ()[(size_t)m * 32 + F.lane] = F.lane == 0 ? f2bf(s) : (bf16)0;
    }
}
DI void final_norm_phase(const Args& A, Frame& F, const float* w) {
    const int gw = F.bid * NWAVES + F.wave, NGW = F.G * NWAVES;
    f32x4 wv[4];
#pragma unroll
    for (int j = 0; j < 4; ++j) wv[j] = *((const f32x4*)w + F.lane + 64 * j);
    for (int m = gw; m < M; m += NGW) {
        const v2u* xb = (const v2u*)(F.pXB() + (size_t)m * D) + F.lane;
        f32x4 v[4]; float s = 0.f;
#pragma unroll
        for (int j = 0; j < 4; ++j) { const v2u q = xb[64 * j]; v[j] = (f32x4){bflo(q.x), bfhi(q.x), bflo(q.y), bfhi(q.y)}; s += (v[j].x * v[j].x + v[j].y * v[j].y) + (v[j].z * v[j].z + v[j].w * v[j].w); }
        const float rstd = rsqrtf(wave_sum(s) * (1.f / D) + EPS);
        f32x4* xr = (f32x4*)(F.pX() + (size_t)m * D) + F.lane;
#pragma unroll
        for (int j = 0; j < 4; ++j) xr[64 * j] = v[j] * rstd * wv[j];
    }
}

DI void ld8(const bf16* p, float (&o)[8]) { const v4u w = *(const v4u*)p; o[0] = bflo(w.x); o[1] = bfhi(w.x); o[2] = bflo(w.y); o[3] = bfhi(w.y); o[4] = bflo(w.z); o[5] = bfhi(w.z); o[6] = bflo(w.w); o[7] = bfhi(w.w); }
DI void ld8f(const float* p, float (&o)[8]) { const f32x4 a = *(const f32x4*)p, b = *((const f32x4*)p + 1); o[0] = a.x; o[1] = a.y; o[2] = a.z; o[3] = a.w; o[4] = b.x; o[5] = b.y; o[6] = b.z; o[7] = b.w; }
DI void st8f(float* p, const float (&o)[8]) { *(f32x4*)p = (f32x4){o[0], o[1], o[2], o[3]}; *((f32x4*)p + 1) = (f32x4){o[4], o[5], o[6], o[7]}; }
DI v4u pk8(const float (&o)[8]) { v4u w; w.x = pk2(o[0], o[1]); w.y = pk2(o[2], o[3]); w.z = pk2(o[4], o[5]); w.w = pk2(o[6], o[7]); return w; }

DI void ffn_fix_panel(const Args& A, Frame& F, int l, int pm) {
    constexpr int OCT = DFF / 8;
    const float* cw = F.in(22) + (size_t)l * 3 * DFF;
    const int tid = fresh_tid();
    if (tid < OCT) {
        const int L = tid * 8;
        float w0[8], w1[8], w2[8]; ld8f(cw + L, w0); ld8f(cw + DFF + L, w1); ld8f(cw + 2 * DFF + L, w2);
        float h0[8], h1[8], g0[8], g1[8], v0[8], v1[8];
        ld8f(F.pHALO() + ((size_t)(pm - 1) * 2 + 0) * DFF + L, h0); ld8f(F.pHALO() + ((size_t)(pm - 1) * 2 + 1) * DFF + L, h1);
        ld8f(F.pFIX() + ((size_t)(pm * 2 + 0) * 2) * DFF + L, g0); ld8f(F.pFIX() + ((size_t)(pm * 2 + 0) * 2 + 1) * DFF + L, v0);
        ld8f(F.pFIX() + ((size_t)(pm * 2 + 1) * 2) * DFF + L, g1); ld8f(F.pFIX() + ((size_t)(pm * 2 + 1) * 2 + 1) * DFF + L, v1);
        float o0[8], o1[8];
#pragma unroll
        for (int e = 0; e < 8; ++e) { const float a0 = w0[e] * h0[e] + w1[e] * h1[e] + w2[e] * g0[e], a1 = w0[e] * h1[e] + w1[e] * g0[e] + w2[e] * g1[e]; o0[e] = siluf(a0) * v0[e]; o1[e] = siluf(a1) * v1[e]; }
        *(v4u*)(F.pACT() + (size_t)(pm * 256) * DFF + L) = pk8(o0);
        *(v4u*)(F.pACT() + (size_t)(pm * 256 + 1) * DFF + L) = pk8(o1);
    }
}
DI void sconv_local_prompt(const Args& A, Frame& F, int i, int pm, int t) {
    const int tid = fresh_tid(); const int c = 256 * t + 8 * (tid & 31);
    const float* cw = F.in(19) + (size_t)i * 3 * D;
    float w0[8], w1[8], w2[8]; ld8f(cw + c, w0); ld8f(cw + D + c, w1); ld8f(cw + 2 * D + c, w2);
    const bool start = (pm & 7) == 0;
#pragma unroll 1
    for (int k0 = 0; k0 < 16; k0 += 4) {
        v4u qb[4], q0[4], q1[4], q2[4];
#pragma unroll
        for (int u = 0; u < 4; ++u) { const int r = (tid >> 5) + 16 * (k0 + u); const bf16* p = F.pRAW() + (size_t)(pm * 256 + r) * 2048 + c;
            qb[u] = *(const v4u*)p; q0[u] = *(const v4u*)(p + D);
            q1[u] = r >= 1 ? *(const v4u*)(p + D - 2048) : (v4u){0u, 0u, 0u, 0u};
            q2[u] = r >= 2 ? *(const v4u*)(p + D - 4096) : (v4u){0u, 0u, 0u, 0u}; }
#pragma unroll
        for (int u = 0; u < 4; ++u) { const int r = (tid >> 5) + 16 * (k0 + u), m = pm * 256 + r, pos = m & (SEQ - 1);
            const unsigned wb[4] = {qb[u].x, qb[u].y, qb[u].z, qb[u].w}, wg0[4] = {q0[u].x, q0[u].y, q0[u].z, q0[u].w}, wg1[4] = {q1[u].x, q1[u].y, q1[u].z, q1[u].w}, wg2[4] = {q2[u].x, q2[u].y, q2[u].z, q2[u].w};
            float o[8], g0[8];
#pragma unroll
            for (int e = 0; e < 4; ++e) { g0[2 * e] = bflo(wg0[e]); g0[2 * e + 1] = bfhi(wg0[e]);
                o[2 * e] = bflo(wb[e]) * (w0[2 * e] * bflo(wg2[e]) + w1[2 * e] * bflo(wg1[e]) + w2[2 * e] * g0[2 * e]);
                o[2 * e + 1] = bfhi(wb[e]) * (w0[2 * e + 1] * bfhi(wg2[e]) + w1[2 * e + 1] * bfhi(wg1[e]) + w2[2 * e + 1] * g0[2 * e + 1]); }
            if (pos >= SEQ - 2) st8f(F.out + O_SC_P + ((size_t)(i * NB + (m >> 11)) * 2 + (pos - (SEQ - 2))) * D + c, g0);
            if (r >= 2 || start) *(v4u*)(F.pH() + (size_t)m * D + c) = pk8(o); }
    }
}
DI void sconv_fix_panel(const Args& A, Frame& F, int i, int pm) {
    const int tid = fresh_tid();
    if (tid < 256) { const int c = 8 * (tid & 127), m = pm * 256 + (tid >> 7);
        const float* cw = F.in(19) + (size_t)i * 3 * D;
        float w0[8], w1[8], w2[8]; ld8f(cw + c, w0); ld8f(cw + D + c, w1); ld8f(cw + 2 * D + c, w2);
        float bb[8], g0[8], g1[8], g2[8]; ld8(F.pRAW() + (size_t)m * 2048 + c, bb); ld8(F.pRAW() + (size_t)m * 2048 + D + c, g0);
        ld8(F.pRAW() + (size_t)(m - 1) * 2048 + D + c, g1); ld8(F.pRAW() + (size_t)(m - 2) * 2048 + D + c, g2);
        float o[8];
#pragma unroll
        for (int e = 0; e < 8; ++e) o[e] = bb[e] * (w0[e] * g2[e] + w1[e] * g1[e] + w2[e] * g0[e]);
        *(v4u*)(F.pH() + (size_t)m * D + c) = pk8(o); }
}
DI void sconv_local_sample(const Args& A, Frame& F, int i, int rb, int cq) {
    const int tid = fresh_tid(); const int c = 64 * cq + 8 * (tid & 7), r = tid >> 3, m = MP + 64 * rb + r, s = (64 * rb + r) >> 3, tau = r & 7;
    const float* cw = F.in(19) + (size_t)i * 3 * D;
    const float* sp = F.in(5) + (size_t)i * NS * 2 * D + (size_t)s * 2 * D + c;
    float w0[8], w1[8], w2[8]; ld8f(cw + c, w0); ld8f(cw + D + c, w1); ld8f(cw + 2 * D + c, w2);
    float bb[8], g0[8], p1[8], p2[8]; ld8(F.pRAW() + (size_t)m * 2048 + c, bb); ld8(F.pRAW() + (size_t)m * 2048 + D + c, g0);
    if (tau >= 1) ld8(F.pRAW() + (size_t)(m - 1) * 2048 + D + c, p1); else ld8f(sp + D, p1);
    if (tau >= 2) ld8(F.pRAW() + (size_t)(m - 2) * 2048 + D + c, p2); else ld8f(sp + (tau == 0 ? 0 : D), p2);
    if (tau >= 6) st8f(F.out + O_SC_S + ((size_t)(i * NS + s) * 2 + (tau - 6)) * D + c, g0);
    float o[8];
#pragma unroll
    for (int e = 0; e < 8; ++e) o[e] = bb[e] * (w0[e] * p2[e] + w1[e] * p1[e] + w2[e] * g0[e]);
    *(v4u*)(F.pH() + (size_t)m * D + c) = pk8(o);
}
DI void pool_unit(const Args& A, Frame& F, int li, int rb, int g) {
    const int tid_ = fresh_tid(); const int lane_ = tid_ & 63, wave_ = __builtin_amdgcn_readfirstlane(tid_ >> 6);
    const int w = 2 << g;
    LAS unsigned short* Y = (LAS unsigned short*)F.lds;
    const int cq = tid_ & 31, rg = tid_ >> 5;
    const int c0 = 128 * g + 4 * cq, r0 = 4 * rg, m0 = 64 * rb + r0;
    const bool prompt = rb < 256;
    const int pbase = prompt ? ((rb & 31) * 64 + r0) : 0;
    const int s = prompt ? 0 : (m0 - MP) >> 3, tau0 = prompt ? 0 : (m0 - MP) & 7;
    const float* stp = F.in(2) + ((size_t)(li * NS + s) * 15) * 512;
    const int fr = lane_ & 15, fq = lane_ >> 4, wv = wave_;
    const bf16* wt = F.pPoolW() + ((size_t)(li * 4 + g) * 128 + 16 * wv + fr) * 128 + 8 * fq;
    bf16x8 Bw[4];
#pragma unroll
    for (int ks = 0; ks < 4; ++ks) Bw[ks] = *(const bf16x8*)(wt + 32 * ks);
    const f32x4 ps = *(const f32x4*)(F.in(12) + (size_t)li * 512 + 128 * g + 16 * wv + 4 * fq);
    float vals[19][4];
#pragma unroll
    for (int e = 0; e < 19; ++e) {
        const int off = e - 15;
        float x0 = 0.f, x1 = 0.f, x2 = 0.f, x3 = 0.f;
        if (off >= 1 - w) {
            if (prompt) { if (pbase + off >= 0) { const v2u q = *(const v2u*)(F.pRAW() + (size_t)(m0 + off) * NABP + c0); x0 = bflo(q.x); x1 = bfhi(q.x); x2 = bflo(q.y); x3 = bfhi(q.y); } }
            else { const int tp = tau0 + off;
                if (tp >= 0) { const v2u q = *(const v2u*)(F.pRAW() + (size_t)(m0 + off) * NABP + c0); x0 = bflo(q.x); x1 = bfhi(q.x); x2 = bflo(q.y); x3 = bfhi(q.y); }
                else { const f32x4 q = *(const f32x4*)(stp + (size_t)(15 + tp) * 512 + c0); x0 = q.x; x1 = q.y; x2 = q.z; x3 = q.w; } }
        }
        vals[e][0] = x0; vals[e][1] = x1; vals[e][2] = x2; vals[e][3] = x3;
    }
    float S[4] = {0.f, 0.f, 0.f, 0.f};
#pragma unroll
    for (int d = 0; d < 16; ++d) if (d < w) {
#pragma unroll
        for (int k = 0; k < 4; ++k) S[k] += vals[15 - d][k]; }
#pragma unroll
    for (int rr = 0; rr < 4; ++rr) {
        if (rr > 0) {
#pragma unroll
            for (int k = 0; k < 4; ++k) { float old = 0.f;
#pragma unroll
                for (int e = 0; e < 19; ++e) if (e == 15 + rr - w) old = vals[e][k];
                S[k] += vals[15 + rr][k] - old; } }
        const int cnt = prompt ? ((pbase + rr + 1) < w ? (pbase + rr + 1) : w) : w;
        const float inv = 1.f / (float)cnt;
        v2u o; o.x = pk2(S[0] * inv - vals[15 + rr][0], S[1] * inv - vals[15 + rr][1]); o.y = pk2(S[2] * inv - vals[15 + rr][2], S[3] * inv - vals[15 + rr][3]);
        *(LAS v2u*)(Y + (r0 + rr) * 136 + 4 * cq) = o;
    }
    if (prompt) { if ((rb & 31) == 31 && r0 >= 48) {
#pragma unroll
            for (int rr = 0; rr < 4; ++rr) { const int r = r0 + rr; if (r >= 49)
                *(f32x4*)(F.out + O_POOL_P + ((size_t)((li * NB + (rb >> 5)) * 15 + (r - 49))) * 512 + c0) = (f32x4){vals[15 + rr][0], vals[15 + rr][1], vals[15 + rr][2], vals[15 + rr][3]}; } }
    } else {
        float* op = F.out + O_POOL_S + ((size_t)(li * NS + s) * 15) * 512 + c0;
        if (tau0 == 0) {
#pragma unroll
            for (int j = 0; j < 7; ++j) *(f32x4*)(op + (size_t)j * 512) = *(const f32x4*)(stp + (size_t)(8 + j) * 512 + c0);
        }
#pragma unroll
        for (int rr = 0; rr < 4; ++rr) *(f32x4*)(op + (size_t)(7 + tau0 + rr) * 512) = (f32x4){vals[15 + rr][0], vals[15 + rr][1], vals[15 + rr][2], vals[15 + rr][3]};
    }
    __syncthreads();
#pragma unroll
    for (int mi = 0; mi < 4; ++mi) {
        f32x4 acc = {0.f, 0.f, 0.f, 0.f};
#pragma unroll
        for (int ks = 0; ks < 4; ++ks) { const bf16x8 ya = *(const LAS bf16x8*)(Y + (16 * mi + fr) * 136 + 32 * ks + 8 * fq); acc = MFMA16(Bw[ks], ya, acc); }
        v2u o; o.x = pk2(acc[0] * ps[0], acc[1] * ps[1]); o.y = pk2(acc[2] * ps[2], acc[3] * ps[3]);
        *(v2u*)(F.pH() + (size_t)(64 * rb + 16 * mi + fr) * D + 128 * g + 16 * wv + 4 * fq) = o;
    }
    __syncthreads();
}
typedef float f32x2 __attribute__((ext_vector_type(2)));
template <int I, int K>
DI void subst_ld(f32x4 (&dst)[4], const LAS float* Lm) {
#pragma unroll
    for (int v = 0; v < 4; ++v) if (16 * K + 4 * v < I) dst[v] = *(const LAS f32x4*)(Lm + I * 68 + 16 * K + 4 * v);
}
template <int I, int K, int Q>
DI void subst_step(f32x2 (&cx)[32], f32x2 (&cy)[32], f32x4 (&R)[3][4], const LAS float* Lm, f32x2& ax, f32x2& ay) {
    constexpr int N = (I + 15) >> 4;
    constexpr int i1 = (K + 1 < N) ? I : I + 1, k1 = (K + 1 < N) ? K + 1 : 0;
    constexpr int n1 = (i1 + 15) >> 4;
    constexpr int i2 = (k1 + 1 < n1) ? i1 : i1 + 1, k2 = (k1 + 1 < n1) ? k1 + 1 : 0;
    if constexpr (i2 < 64) subst_ld<i2, k2>(R[(Q + 2) % 3], Lm);
    __builtin_amdgcn_sched_barrier(0);
    if constexpr (K == 0) { ax = (f32x2){cx[I >> 1][I & 1], 0.f}; ay = (f32x2){cy[I >> 1][I & 1], 0.f}; }
#pragma unroll
    for (int v = 0; v < 4; ++v)
#pragma unroll
        for (int p = 0; p < 2; ++p) { const int j0 = 16 * K + 4 * v + 2 * p;
            if (j0 + 1 < I) { const f32x2 ll = {R[Q % 3][v][2 * p], R[Q % 3][v][2 * p + 1]}; ax -= ll * cx[j0 >> 1]; ay -= ll * cy[j0 >> 1]; }
            else if (j0 < I) { const float l = R[Q % 3][v][2 * p]; ax[0] -= l * cx[j0 >> 1][0]; ay[0] -= l * cy[j0 >> 1][0]; } }
    if constexpr (K + 1 == N) { cx[I >> 1][I & 1] = ax[0] + ax[1]; cy[I >> 1][I & 1] = ay[0] + ay[1]; }
    __builtin_amdgcn_sched_barrier(0);
    if constexpr (i1 < 64) subst_step<i1, k1, Q + 1>(cx, cy, R, Lm, ax, ay);
}
constexpr int DP_R0 = 0, DP_R1 = 17408, DP_R2 = 35840, DP_R3 = 53248, DP_GS = 70656, DP_HALF = 73728;
DI void dnprep_round(const Args& A, Frame& F, int li, int unit, bool active) {
    const int tid_ = fresh_tid(); const int half = tid_ >> 8, ht = tid_ & 255, hw = __builtin_amdgcn_readfirstlane(ht >> 6), lane = tid_ & 63;
    LAS unsigned char* LB = F.lds + half * DP_HALF;
    LAS float* GS = (LAS float*)(LB + DP_GS);
    const int n = unit & 31, h = (unit >> 5) & 3, b = unit >> 7;
    const int tb = b * SEQ + n * 64;
    unsigned char* rec = F.pREC() + (size_t)unit * RECSZ;
    if (active) {
        if (ht < 192) {
            const int cq = ht % 96, seg = ht / 96, part = cq >> 5, c4 = (cq & 31) * 4;
            const int ch = part * 512 + 128 * h + c4;
            const float* cw = F.in(13) + (size_t)li * 4 * 1536 + ch;
            const f32x4 w0 = *(const f32x4*)cw, w1 = *(const f32x4*)(cw + 1536), w2 = *(const f32x4*)(cw + 2 * 1536), w3 = *(const f32x4*)(cw + 3 * 1536);
            const bf16* rp = F.pRAW() + (size_t)(tb + 32 * seg) * NABP + 512 + ch;
            f32x4 h3 = {0.f, 0.f, 0.f, 0.f}, h2 = h3, h1 = h3;
            if (!(n == 0 && seg == 0)) { const v2u a = *(const v2u*)(rp - 3 * NABP), b2 = *(const v2u*)(rp - 2 * NABP), c2 = *(const v2u*)(rp - NABP);
                h3 = (f32x4){bflo(a.x), bfhi(a.x), bflo(a.y), bfhi(a.y)}; h2 = (f32x4){bflo(b2.x), bfhi(b2.x), bflo(b2.y), bfhi(b2.y)}; h1 = (f32x4){bflo(c2.x), bfhi(c2.x), bflo(c2.y), bfhi(c2.y)}; }
            LAS unsigned char* tile = LB + (part == 0 ? DP_R0 : (part == 1 ? DP_R1 : DP_R2));
            float* dnc = F.out + O_DNC_P + ((size_t)(li * NB + b) * 3) * 1536 + ch;
            v2u rawv[32];
#pragma unroll
            for (int r = 0; r < 32; ++r) rawv[r] = *(const v2u*)(rp + (size_t)r * NABP);
#pragma unroll
            for (int r = 0; r < 32; ++r) {
                const v2u cu = rawv[r];
                const f32x4 c = {bflo(cu.x), bfhi(cu.x), bflo(cu.y), bfhi(cu.y)};
                const f32x4 a = w0 * h3 + w1 * h2 + w2 * h1 + w3 * c;
                v2u o; o.x = pk2(a[0] * __builtin_amdgcn_rcpf(1.f + __expf(-a[0])), a[1] * __builtin_amdgcn_rcpf(1.f + __expf(-a[1])));
                o.y = pk2(a[2] * __builtin_amdgcn_rcpf(1.f + __expf(-a[2])), a[3] * __builtin_amdgcn_rcpf(1.f + __expf(-a[3])));
                *(LAS v2u*)(tile + ((32 * seg + r) * 136 + c4) * 2) = o;
                if (n == 31 && seg == 1 && r >= 29) *(f32x4*)(dnc + (size_t)(r - 29) * 1536) = c;
                h3 = h2; h2 = h1; h1 = c;
            }
        } else {
            const float bl = bf2f(F.pRAW()[(size_t)(tb + lane) * NABP + 2560 + h]), al = bf2f(F.pRAW()[(size_t)(tb + lane) * NABP + 2564 + h]);
            const float beta = sigmoidf_(bl);
            const float g = -__expf(F.in(14)[li * 4 + h]) * softplusf_(al + F.in(15)[li * 4 + h]);
            float gc = g;
#pragma unroll
            for (int o = 1; o < 64; o <<= 1) { const float t = __int_as_float(__builtin_amdgcn_ds_bpermute((lane >= o ? lane - o : lane) << 2, __float_as_int(gc))); if (lane >= o) gc += t; }
            const float gcl = __int_as_float(__builtin_amdgcn_readlane(__float_as_int(gc), 63));
            GS[lane] = beta; GS[64 + lane] = gc; GS[128 + lane] = beta * __expf(gc); GS[192 + lane] = __expf(gcl - gc); if (lane == 63) GS[256] = gc;
        }
    }
    __syncthreads();
    if (active) {
        const int row = ht >> 2, wk = (ht >> 1) & 1, hf = ht & 1;
        LAS unsigned char* p = LB + (wk ? DP_R1 : DP_R0) + (row * 136 + 64 * hf) * 2;
        v4u x[8]; float ss = 0.f;
#pragma unroll
        for (int e = 0; e < 8; ++e) { x[e] = *(const LAS v4u*)(p + 16 * e);
            const float a0 = bflo(x[e].x), a1 = bfhi(x[e].x), a2 = bflo(x[e].y), a3 = bfhi(x[e].y), a4 = bflo(x[e].z), a5 = bfhi(x[e].z), a6 = bflo(x[e].w), a7 = bfhi(x[e].w);
            ss += ((a0 * a0 + a1 * a1) + (a2 * a2 + a3 * a3)) + ((a4 * a4 + a5 * a5) + (a6 * a6 + a7 * a7)); }
        ss += __shfl_xor(ss, 1);
        const float rn = rsqrtf(ss + EPS) * (wk ? 1.f : 0.08838834764831845f);
#pragma unroll
        for (int e = 0; e < 8; ++e) { v4u o; o.x = pk2(bflo(x[e].x) * rn, bfhi(x[e].x) * rn); o.y = pk2(bflo(x[e].y) * rn, bfhi(x[e].y) * rn); o.z = pk2(bflo(x[e].z) * rn, bfhi(x[e].z) * rn); o.w = pk2(bflo(x[e].w) * rn, bfhi(x[e].w) * rn);
            *(LAS v4u*)(p + 16 * e) = o; }
    }
    __syncthreads();
    if (active) {
        const int mi = hw, fr = lane & 15, fq = lane >> 4, i = 16 * mi + fr;
        const float gci = GS[64 + i], bi = GS[i];
        bf16x8 Yq[4], Yk[4];
#pragma unroll
        for (int ks = 0; ks < 4; ++ks) { Yq[ks] = *(const LAS bf16x8*)(LB + DP_R0 + (i * 136 + 32 * ks + 8 * fq) * 2); Yk[ks] = *(const LAS bf16x8*)(LB + DP_R1 + (i * 136 + 32 * ks + 8 * fq) * 2); }
        v2u aq[4];
#pragma unroll
        for (int nj = 0; nj < 4; ++nj) {
            aq[nj] = (v2u){0u, 0u};
            if (nj <= mi) {
                f32x4 accQ = {0.f, 0.f, 0.f, 0.f}, accK = {0.f, 0.f, 0.f, 0.f};
#pragma unroll
                for (int ks = 0; ks < 4; ++ks) { const bf16x8 X = *(const LAS bf16x8*)(LB + DP_R1 + ((16 * nj + fr) * 136 + 32 * ks + 8 * fq) * 2); accQ = MFMA16(X, Yq[ks], accQ); accK = MFMA16(X, Yk[ks], accK); }
                float a4[4]; f32x4 l4;
#pragma unroll
                for (int r = 0; r < 4; ++r) { const int j = 16 * nj + 4 * fq + r; const float gcj = GS[64 + j];
                    const float dec = (j <= i) ? __expf(gci - gcj) : 0.f;
                    a4[r] = accQ[r] * dec; l4[r] = (j < i) ? bi * accK[r] * dec : 0.f; }
                aq[nj] = (v2u){pk2(a4[0], a4[1]), pk2(a4[2], a4[3])};
                *(LAS f32x4*)(LB + DP_R3 + (i * 68 + 16 * nj + 4 * fq) * 4) = l4;
            }
        }
#pragma unroll
        for (int js = 0; js < 2; ++js) *(v4u*)(rec + REC_AQK + (size_t)((mi * 2 + js) * 64 + lane) * 16) = (v4u){aq[2 * js].x, aq[2 * js].y, aq[2 * js + 1].x, aq[2 * js + 1].y};
    }
    const int aw = hw - 2 * half; const bool sact = active && (aw == 0 || aw == 1); const bool kthr = aw == 0;
    f32x2 cx[32], cy[32];
    if (sact) {
        const LAS unsigned* tp = (const LAS unsigned*)(LB + (kthr ? DP_R1 : DP_R2)) + lane;
        const LAS float* cf = GS + (kthr ? 128 : 0);
#pragma unroll
        for (int i = 0; i < 64; ++i) { const unsigned q = tp[i * 68]; const float sc = cf[i]; cx[i >> 1][i & 1] = bflo(q) * sc; cy[i >> 1][i & 1] = bfhi(q) * sc; }
    }
    __syncthreads();
    if (sact) {
        const LAS float* Lm = (const LAS float*)(LB + DP_R3);
        asm volatile("" : "+v"(Lm));
        f32x4 R[3][4]; f32x2 ax, ay;
        subst_ld<1, 0>(R[0], Lm); subst_ld<2, 0>(R[1], Lm);
        __builtin_amdgcn_sched_barrier(0);
        subst_step<1, 0, 0>(cx, cy, R, Lm, ax, ay);
    } else if (active) {
        const int it = (half == 0 ? hw - 2 : hw) * 64 + lane;
#pragma unroll 1
        for (int e = 0; e < 8; ++e) { const int p = it + 128 * e; const int fr_ = p >> 6, ln = p & 63, qq = ln >> 4, cc = ln & 15;
            { const int mi = fr_ >> 2, ks = fr_ & 3, i = 16 * mi + cc, ka = 32 * ks + 4 * qq; const float gm = __expf(GS[64 + i]);
              const v2u a = *(const LAS v2u*)(LB + DP_R0 + (i * 136 + ka) * 2), bq = *(const LAS v2u*)(LB + DP_R0 + (i * 136 + ka + 16) * 2);
              *(v4u*)(rec + REC_QG + (size_t)p * 16) = (v4u){pk2(bflo(a.x) * gm, bfhi(a.x) * gm), pk2(bflo(a.y) * gm, bfhi(a.y) * gm), pk2(bflo(bq.x) * gm, bfhi(bq.x) * gm), pk2(bflo(bq.y) * gm, bfhi(bq.y) * gm)}; }
            { const int kf = fr_ >> 1, js = fr_ & 1, k = 16 * kf + cc, ia = 32 * js + 4 * qq;
              const LAS unsigned short* kp = (const LAS unsigned short*)(LB + DP_R1) + k;
              float v[8];
#pragma unroll
              for (int j = 0; j < 8; ++j) { const int i = ia + (j & 3) + 16 * (j >> 2); v[j] = bf2f(kp[i * 136]) * GS[192 + i]; }
              *(v4u*)(rec + REC_KDT + (size_t)p * 16) = (v4u){pk2(v[0], v[1]), pk2(v[2], v[3]), pk2(v[4], v[5]), pk2(v[6], v[7])}; }
        }
    }
    __syncthreads();
    if (sact) {
        if (kthr) {
#pragma unroll
            for (int i = 0; i < 64; ++i) ((LAS unsigned*)(LB + DP_R0))[i * 68 + lane] = pk2(-cx[i >> 1][i & 1], -cy[i >> 1][i & 1]);
        } else {
#pragma unroll
            for (int j = 0; j < 8; ++j) {
                *(LAS v4u*)(LB + DP_R1 + ((2 * lane) * 72 + 8 * j) * 2) = (v4u){pk2(cx[4 * j][0], cx[4 * j][1]), pk2(cx[4 * j + 1][0], cx[4 * j + 1][1]), pk2(cx[4 * j + 2][0], cx[4 * j + 2][1]), pk2(cx[4 * j + 3][0], cx[4 * j + 3][1])};
                *(LAS v4u*)(LB + DP_R1 + ((2 * lane + 1) * 72 + 8 * j) * 2) = (v4u){pk2(cy[4 * j][0], cy[4 * j][1]), pk2(cy[4 * j + 1][0], cy[4 * j + 1][1]), pk2(cy[4 * j + 2][0], cy[4 * j + 2][1]), pk2(cy[4 * j + 3][0], cy[4 * j + 3][1])};
            }
        }
    }
    __syncthreads();
    if (active) {
#pragma unroll 1
        for (int e = 0; e < 4; ++e) { const int p = ht + 256 * e; const int fr_ = p >> 6, ln = p & 63, qq = ln >> 4, cc = ln & 15;
            const int mi = fr_ >> 2, ks = fr_ & 3, i = 16 * mi + cc, ka = 32 * ks + 4 * qq;
            const v2u a = *(const LAS v2u*)(LB + DP_R0 + (i * 136 + ka) * 2), bq = *(const LAS v2u*)(LB + DP_R0 + (i * 136 + ka + 16) * 2);
            *(v4u*)(rec + REC_NEGW + (size_t)p * 16) = (v4u){a.x, a.y, bq.x, bq.y}; }
#pragma unroll 1
        for (int e = 0; e < 8; ++e) { const int p = ht + 256 * e; const int fr_ = p >> 6, ln = p & 63, qq = ln >> 4, cc = ln & 15;
            const int vs = fr_ >> 2, mi = fr_ & 3, v = 16 * vs + cc, i = 16 * mi + 4 * qq;
            *(v2u*)(rec + REC_U + (size_t)p * 8) = *(const LAS v2u*)(LB + DP_R1 + (v * 72 + i) * 2); }
        if (ht == 0) *(float*)(rec + REC_GE) = __expf(GS[256]);
    }
    __syncthreads();
}
constexpr int SC_A0 = 0, SC_A1 = 57344, SC_OB = 114688;
DI void scan_block(const Args& A, Frame& F, int li, int bh) {
    const int tid = fresh_tid(); const int lane = tid & 63, vs = __builtin_amdgcn_readfirstlane(tid >> 6);
    const int b = bh >> 2, h = bh & 3, fq = lane >> 4, fc_ = lane & 15;
    const unsigned char* rec0 = F.pREC() + (size_t)(bh * 32) * RECSZ;
    f32x4 Hf[8]; bf16x8 Hb[4];
#pragma unroll
    for (int k = 0; k < 8; ++k) Hf[k] = (f32x4){0.f, 0.f, 0.f, 0.f};
#pragma unroll
    for (int k = 0; k < 4; ++k) Hb[k] = (bf16x8){0, 0, 0, 0, 0, 0, 0, 0};
#pragma unroll
    for (int e = 0; e < 7; ++e) { const int p = tid + 512 * e; *(LAS v4u*)(F.lds + SC_A0 + p * 16) = *(const v4u*)(rec0 + (size_t)p * 16); }
    LAS float* OB = (LAS float*)(F.lds + SC_OB);
    const int gi = tid >> 3, gc_ = tid & 7;
    const bf16* zbase = F.pRAW() + (size_t)(b * SEQ + gi) * NABP + 2048 + 128 * h + 16 * gc_;
    v2u un[4]; float gen; v4u zn0, zn1;
#pragma unroll
    for (int mi = 0; mi < 4; ++mi) un[mi] = *(const v2u*)(rec0 + REC_U + (size_t)((vs * 4 + mi) * 64 + lane) * 8);
    gen = *(const float*)(rec0 + REC_GE); zn0 = *(const v4u*)zbase; zn1 = *(const v4u*)(zbase + 8);
    __syncthreads();
#pragma unroll 1
    for (int n = 0; n < 32; ++n) {
        const unsigned char* rec = rec0 + (size_t)n * RECSZ;
        LAS unsigned char* Acur = F.lds + ((n & 1) ? SC_A1 : SC_A0);
        const float ge = gen; const v4u z0 = zn0, z1 = zn1;
        f32x4 au[4];
#pragma unroll
        for (int mi = 0; mi < 4; ++mi) au[mi] = (f32x4){bflo(un[mi].x), bfhi(un[mi].x), bflo(un[mi].y), bfhi(un[mi].y)};
        v4u pre[7];
        if (n + 1 < 32) {
#pragma unroll
            for (int e = 0; e < 7; ++e) pre[e] = *(const v4u*)(rec + RECSZ + (size_t)(tid + 512 * e) * 16);
#pragma unroll
            for (int mi = 0; mi < 4; ++mi) un[mi] = *(const v2u*)(rec + RECSZ + REC_U + (size_t)((vs * 4 + mi) * 64 + lane) * 8);
            gen = *(const float*)(rec + RECSZ + REC_GE);
            zn0 = *(const v4u*)(zbase + (size_t)(n + 1) * 64 * NABP); zn1 = *(const v4u*)(zbase + (size_t)(n + 1) * 64 * NABP + 8);
        }
#define LDB(dst, off) do { _Pragma("unroll") for (int e_ = 0; e_ < 8; ++e_) dst[e_] = *(const LAS bf16x8*)(Acur + (off) + (e_ * 64 + lane) * 16); asm volatile("" ::: "memory"); } while (0)
        bf16x8 fa[8], fb[8], fc[8];
        LDB(fa, REC_NEGW); LDB(fb, REC_NEGW + 8192); LDB(fc, REC_QG);
#pragma unroll
        for (int e = 0; e < 8; ++e) au[e >> 2] = MFMA16(fa[e], Hb[e & 3], au[e >> 2]);
        LDB(fa, REC_QG + 8192);
#pragma unroll
        for (int e = 0; e < 8; ++e) au[2 + (e >> 2)] = MFMA16(fb[e], Hb[e & 3], au[2 + (e >> 2)]);
        LDB(fb, REC_AQK);
        bf16x8 ub[2];
        ub[0] = pack8(au[0], au[1]); ub[1] = pack8(au[2], au[3]);
        f32x4 ao[4];
#pragma unroll
        for (int mi = 0; mi < 4; ++mi) ao[mi] = (f32x4){0.f, 0.f, 0.f, 0.f};
#pragma unroll
        for (int e = 0; e < 8; ++e) ao[e >> 2] = MFMA16(fc[e], Hb[e & 3], ao[e >> 2]);
        LDB(fc, REC_KDT);
#pragma unroll
        for (int e = 0; e < 8; ++e) ao[2 + (e >> 2)] = MFMA16(fa[e], Hb[e & 3], ao[2 + (e >> 2)]);
        LDB(fa, REC_KDT + 8192);
#pragma unroll
        for (int e = 0; e < 8; ++e) ao[e >> 1] = MFMA16(fb[e], ub[e & 1], ao[e >> 1]);
#pragma unroll
        for (int mi = 0; mi < 4; ++mi)
#pragma unroll
            for (int r = 0; r < 4; ++r) OB[(16 * mi + 4 * fq + r) * 132 + 16 * vs + fc_ + 0] = ao[mi][r];
#pragma unroll
        for (int kf = 0; kf < 8; ++kf) Hf[kf] = Hf[kf] * ge;
#pragma unroll
        for (int e = 0; e < 8; ++e) Hf[e >> 1] = MFMA16(fc[e], ub[e & 1], Hf[e >> 1]);
#pragma unroll
        for (int e = 0; e < 8; ++e) Hf[4 + (e >> 1)] = MFMA16(fa[e], ub[e & 1], Hf[4 + (e >> 1)]);
#undef LDB
#pragma unroll
        for (int ks = 0; ks < 4; ++ks) Hb[ks] = pack8(Hf[2 * ks], Hf[2 * ks + 1]);
        __syncthreads();
        { float o[16];
#pragma unroll
          for (int e = 0; e < 4; ++e) { const f32x4 t = *(const LAS f32x4*)(OB + gi * 132 + 16 * gc_ + 4 * e); o[4 * e] = t.x; o[4 * e + 1] = t.y; o[4 * e + 2] = t.z; o[4 * e + 3] = t.w; }
          float ss = 0.f;
#pragma unroll
          for (int e = 0; e < 16; ++e) ss += o[e] * o[e];
          ss += __shfl_xor(ss, 1); ss += __shfl_xor(ss, 2); ss += __shfl_xor(ss, 4);
          const float rstd = rsqrtf(ss * (1.f / 128.f) + EPS);
          const unsigned zw[8] = {z0.x, z0.y, z0.z, z0.w, z1.x, z1.y, z1.z, z1.w};
          unsigned ow[8];
#pragma unroll
          for (int e = 0; e < 8; ++e) ow[e] = pk2(o[2 * e] * rstd * bflo(zw[e]), o[2 * e + 1] * rstd * bfhi(zw[e]));
          bf16* dst = F.pH() + (size_t)(b * SEQ + n * 64 + gi) * D + 512 + 128 * h + 16 * gc_;
          *(v4u*)dst = (v4u){ow[0], ow[1], ow[2], ow[3]};
          *(v4u*)(dst + 8) = (v4u){ow[4], ow[5], ow[6], ow[7]};
        }
        if (n + 1 < 32) { LAS unsigned char* An = F.lds + ((n & 1) ? SC_A0 : SC_A1);
#pragma unroll
            for (int e = 0; e < 7; ++e) *(LAS v4u*)(An + (tid + 512 * e) * 16) = pre[e]; }
        __syncthreads();
    }
    float* op = F.out + O_DN_P + ((size_t)((li * NB + b) * NH + h) * 128) * 128;
#pragma unroll
    for (int kf = 0; kf < 8; ++kf)
#pragma unroll
        for (int r = 0; r < 4; ++r) op[(size_t)(16 * kf + 4 * fq + r) * 128 + 16 * vs + fc_] = Hf[kf][r];
}

constexpr int SM_QKV = 0, SM_RED = 12288, SM_OB = 20480, SM_G = 24576;
DI void sample_unit(const Args& A, Frame& F, int li, int u) {
    const int tid = fresh_tid(); const int s = u >> 2, h = u & 3, lane = tid & 63, wv = __builtin_amdgcn_readfirstlane(tid >> 6);
    LAS float* QKV = (LAS float*)(F.lds + SM_QKV); LAS float* RED = (LAS float*)(F.lds + SM_RED); LAS float* OBf = (LAS float*)(F.lds + SM_OB); LAS float* GG = (LAS float*)(F.lds + SM_G);
    const int mb = MP + 8 * s;
    const int v = tid & 127, kq = tid >> 7;
    const float* sp = F.in(4) + ((size_t)((li * NS + s) * NH + h) * 128 + 32 * kq) * 128 + v;
    float S[32];
#pragma unroll
    for (int kk = 0; kk < 32; ++kk) S[kk] = sp[(size_t)kk * 128];
    if (tid < 384) {
        const int part = tid >> 7, c = tid & 127, ch = part * 512 + 128 * h + c;
        const float* cw = F.in(13) + (size_t)li * 4 * 1536 + ch;
        const float w0 = cw[0], w1 = cw[1536], w2 = cw[2 * 1536], w3 = cw[3 * 1536];
        const float* stc = F.in(3) + ((size_t)(li * NS + s) * 3) * 1536 + ch;
        float h3 = stc[0], h2 = stc[1536], h1 = stc[2 * 1536];
#pragma unroll
        for (int t = 0; t < 8; ++t) { const float cu = bf2f(F.pRAW()[(size_t)(mb + t) * NABP + 512 + ch]); const float a = w0 * h3 + w1 * h2 + w2 * h1 + w3 * cu; QKV[(part * 8 + t) * 128 + c] = siluf(a);
            if (t >= 5) F.out[O_DNC_S + ((size_t)(li * NS + s) * 3 + (t - 5)) * 1536 + ch] = cu;
            h3 = h2; h2 = h1; h1 = cu; }
    } else if (tid < 392) {
        const int t = tid - 384;
        const float bl = bf2f(F.pRAW()[(size_t)(mb + t) * NABP + 2560 + h]), al = bf2f(F.pRAW()[(size_t)(mb + t) * NABP + 2564 + h]);
        GG[t] = sigmoidf_(bl); GG[8 + t] = __expf(-__expf(F.in(14)[li * 4 + h]) * softplusf_(al + F.in(15)[li * 4 + h]));
    }
    __syncthreads();
#pragma unroll
    for (int e = 0; e < 2; ++e) { const int r = 2 * wv + e; LAS float* row = QKV + r * 128; const float a = row[lane], bq = row[lane + 64];
        const float ss = wave_sum(a * a + bq * bq); const float rn = rsqrtf(ss + EPS) * (r < 8 ? 0.08838834764831845f : 1.f); row[lane] = a * rn; row[lane + 64] = bq * rn; }
    __syncthreads();
    { const float a = QKV[wv * 128 + lane] * QKV[(8 + wv) * 128 + lane] + QKV[wv * 128 + lane + 64] * QKV[(8 + wv) * 128 + lane + 64]; const float qk = wave_sum(a); if (lane == 0) GG[16 + wv] = qk; }
    __syncthreads();
#pragma unroll 1
    for (int t = 0; t < 8; ++t) {
        const LAS float* qv = QKV + t * 128 + 32 * kq; const LAS float* kv = QKV + (8 + t) * 128 + 32 * kq;
        float pk = 0.f, pq = 0.f; float kreg[32];
#pragma unroll
        for (int k4 = 0; k4 < 8; ++k4) { const f32x4 kk4 = *(const LAS f32x4*)(kv + 4 * k4), qq4 = *(const LAS f32x4*)(qv + 4 * k4);
#pragma unroll
            for (int e = 0; e < 4; ++e) { kreg[4 * k4 + e] = kk4[e]; pk += kk4[e] * S[4 * k4 + e]; pq += qq4[e] * S[4 * k4 + e]; } }
        LAS float* rd = RED + (t & 1) * 1024;
        rd[kq * 128 + v] = pk; rd[512 + kq * 128 + v] = pq;
        __syncthreads();
        const float kS = (rd[v] + rd[128 + v]) + (rd[256 + v] + rd[384 + v]);
        const float qS = (rd[512 + v] + rd[640 + v]) + (rd[768 + v] + rd[896 + v]);
        const float gam = GG[8 + t], beta = GG[t], qk = GG[16 + t];
        const float uu = beta * (QKV[(16 + t) * 128 + v] - gam * kS);
        if (kq == 0) OBf[t * 128 + v] = gam * qS + qk * uu;
#pragma unroll
        for (int kk = 0; kk < 32; ++kk) S[kk] = gam * S[kk] + kreg[kk] * uu;
    }
    float* so = F.out + O_DN_S + ((size_t)((li * NS + s) * NH + h) * 128 + 32 * kq) * 128 + v;
#pragma unroll
    for (int kk = 0; kk < 32; ++kk) so[(size_t)kk * 128] = S[kk];
    __syncthreads();
    { const int t = wv; const float a = OBf[t * 128 + lane], bq = OBf[t * 128 + lane + 64];
      const float rstd = rsqrtf(wave_sum(a * a + bq * bq) * (1.f / 128.f) + EPS);
      const float* nw = F.in(16) + (size_t)li * 128; const size_t m = (size_t)(mb + t);
      const float z0 = bf2f(F.pRAW()[m * NABP + 2048 + 128 * h + lane]), z1 = bf2f(F.pRAW()[m * NABP + 2048 + 128 * h + lane + 64]);
      F.pH()[m * D + 512 + 128 * h + lane] = f2bf(a * rstd * z0);
      F.pH()[m * D + 512 + 128 * h + lane + 64] = f2bf(bq * rstd * z1); }
    __syncthreads();
}
struct MicroResNorm { static DI int brow(int cb, int prow) { return 64 * cb + prow; } static DI void remap(int u, int& rb, int& cb) { rb = u & 15; cb = u >> 4; } bf16* XB; bf16* SSQ;
    DI void operator()(const f32x4& a0, const f32x4& a1, int row, int col, int fq) const {
        bf16* p = XB + (size_t)row * D + col; float s = 0.f;
#pragma unroll
        for (int nf = 0; nf < 2; ++nf) { const f32x4 a = nf ? a1 : a0; const v2u o = *(const v2u*)(p + 16 * nf);
            const float t0 = bflo(o.x) + a[0], t1 = bfhi(o.x) + a[1], t2 = bflo(o.y) + a[2], t3 = bfhi(o.y) + a[3];
            s += (t0 * t0 + t1 * t1) + (t2 * t2 + t3 * t3);
            *(v2u*)(p + 16 * nf) = (v2u){pk2(t0, t1), pk2(t2, t3)}; }
        s += __shfl_xor(s, 16); s += __shfl_xor(s, 32);
        if (fq == 0) SSQ[(size_t)row * 32 + (col >> 5)] = f2bf(s);
    } };
struct MicroBf16CX { bf16* O; const bf16* SSQ;
    static DI void remap(int u, int& rb, int& cb) { const int k = u >> 8, c = u & 255; rb = c & 15; cb = k == 0 ? (c >> 4) : 16 + 2 * (c >> 4) + (k - 1); }
    static DI int brow(int cb, int prow) { if (cb < 16) return 64 * cb + prow; const int ch = 32 * (cb - 16) + 16 * (prow >> 5) + (prow & 15); return D + (ch >> 7) * 256 + ((prow >> 4) & 1) * 128 + (ch & 127); }
    DI void operator()(const f32x4& a0, const f32x4& a1, int row, int col, int fq) const {
        const bf16* sp = SSQ + (size_t)row * 32; float s = 0.f;
#pragma unroll
        for (int e = 0; e < 4; ++e) { const v4u t = *(const v4u*)(sp + 8 * e); s += (bflo(t.x) + bfhi(t.x)) + (bflo(t.y) + bfhi(t.y)) + (bflo(t.z) + bfhi(t.z)) + (bflo(t.w) + bfhi(t.w)); }
        const float rs = rsqrtf(s * (1.f / 1024.f) + EPS);
        const int cb = col >> 6;
        if (cb < 16) { bf16* p = O + (size_t)row * 2048 + col;
            *(v2u*)p = (v2u){pk2(a0[0] * rs, a0[1] * rs), pk2(a0[2] * rs, a0[3] * rs)};
            *(v2u*)(p + 16) = (v2u){pk2(a1[0] * rs, a1[1] * rs), pk2(a1[2] * rs, a1[3] * rs)};
        } else { const float r2 = rs * rs; bf16* p = O + (size_t)row * 2048 + 1024 + 32 * (cb - 16) + 16 * ((col >> 5) & 1) + (col & 15);
            *(v2u*)p = (v2u){pk2(a0[0] * a1[0] * r2, a0[1] * a1[1] * r2), pk2(a0[2] * a1[2] * r2, a0[3] * a1[3] * r2)}; }
    } };
struct MicroBf16N { bf16* O; int ldc; const bf16* SSQ;
    static DI void remap(int u, int& rb, int& cb) { rb = u & 15; cb = u >> 4; }
    static DI int brow(int cb, int prow) { return 64 * cb + prow; }
    DI void operator()(const f32x4& a0, const f32x4& a1, int row, int col, int fq) const {
        const bf16* sp = SSQ + (size_t)row * 32; float s = 0.f;
#pragma unroll
        for (int e = 0; e < 4; ++e) { const v4u t = *(const v4u*)(sp + 8 * e); s += (bflo(t.x) + bfhi(t.x)) + (bflo(t.y) + bfhi(t.y)) + (bflo(t.z) + bfhi(t.z)) + (bflo(t.w) + bfhi(t.w)); }
        const float rs = rsqrtf(s * (1.f / 1024.f) + EPS);
        bf16* p = O + (size_t)row * ldc + col;
        *(v2u*)p = (v2u){pk2(a0[0] * rs, a0[1] * rs), pk2(a0[2] * rs, a0[3] * rs)};
        *(v2u*)(p + 16) = (v2u){pk2(a1[0] * rs, a1[1] * rs), pk2(a1[2] * rs, a1[3] * rs)};
    } };
template <class Epi>
DI void micro_phase(Frame& F, const bf16* Am, const bf16* Bt, int K, int N, const Epi& E) {
    const int tid = fresh_tid(); const int lane = tid & 63, wv = __builtin_amdgcn_readfirstlane(tid >> 6), fr = lane & 15, fq = lane >> 4;
    const int mi = wv & 3, nh = wv >> 2;
    const int nunits = 16 * (N >> 6), nchunk = K >> 6;
    LAS unsigned char* ring = F.lds;
    const int prow = tid >> 3, pseg = (tid & 7) ^ (prow & 7);
    int aoff[2], boff[2][2];
#pragma unroll
    for (int ks = 0; ks < 2; ++ks) { const int seg = 4 * ks + fq; { const int r = 16 * mi + fr; aoff[ks] = r * 128 + ((seg ^ (r & 7)) << 4); }
#pragma unroll
        for (int nf = 0; nf < 2; ++nf) { const int r = 32 * nh + 16 * nf + fr; boff[nf][ks] = 8192 + r * 128 + ((seg ^ (r & 7)) << 4); } }
#pragma unroll 1
    for (int u = F.bid; u < nunits; u += F.G) {
        int rb, cb; Epi::remap(u, rb, cb);
        const bf16* ga = Am + (size_t)(MP + 64 * rb + prow) * K + 8 * pseg;
        const bf16* gb = Bt + (size_t)Epi::brow(cb, prow) * K + 8 * pseg;
#define MICRO_ISSUE(c) do { LAS unsigned char* s_ = ring + (((c) & 7) << 14) + (wv << 10); \
        __builtin_amdgcn_global_load_lds((const unsigned*)(ga + ((c) << 6)), (LAS unsigned*)s_, 16, 0, 0); \
        __builtin_amdgcn_global_load_lds((const unsigned*)(gb + ((c) << 6)), (LAS unsigned*)(s_ + 8192), 16, 0, 0); } while (0)
        for (int c = 0; c < 6 && c < nchunk; ++c) MICRO_ISSUE(c);
        f32x4 acc0 = {0.f, 0.f, 0.f, 0.f}, acc1 = {0.f, 0.f, 0.f, 0.f};
#pragma unroll 1
        for (int c = 0; c < nchunk; ++c) {
            if (c + 6 <= nchunk) asm volatile("s_waitcnt vmcnt(10)" ::: "memory"); else asm volatile("s_waitcnt vmcnt(0)" ::: "memory");
            __builtin_amdgcn_s_barrier(); asm volatile("" ::: "memory");
            const LAS unsigned char* sl = ring + ((c & 7) << 14);
            const bf16x8 a0 = *(const LAS bf16x8*)(sl + aoff[0]), a1 = *(const LAS bf16x8*)(sl + aoff[1]);
            const bf16x8 b00 = *(const LAS bf16x8*)(sl + boff[0][0]), b01 = *(const LAS bf16x8*)(sl + boff[0][1]), b10 = *(const LAS bf16x8*)(sl + boff[1][0]), b11 = *(const LAS bf16x8*)(sl + boff[1][1]);
            acc0 = MFMA16(b00, a0, acc0); acc1 = MFMA16(b10, a0, acc1); acc0 = MFMA16(b01, a1, acc0); acc1 = MFMA16(b11, a1, acc1);
            asm volatile("s_waitcnt lgkmcnt(0)" ::: "memory");
            if (c + 6 < nchunk) MICRO_ISSUE(c + 6);
        }
#undef MICRO_ISSUE
        E(acc0, acc1, MP + 64 * rb + 16 * mi + fr, 64 * cb + 32 * nh + 4 * fq, fq);
        asm volatile("s_waitcnt vmcnt(0) lgkmcnt(0)" ::: "memory"); __builtin_amdgcn_s_barrier(); asm volatile("" ::: "memory");
    }
}

constexpr int N_PHASES = 22;
DI void decode_phase(int ph, int& l, int& sub) {
    if (ph == 0) { l = -1; sub = 0; return; }
    if (ph == N_PHASES - 1) { l = 4; sub = 0; return; }
    const int q = ph - 1;
    l = (q >= 16) ? 3 : (q >= 10) ? 2 : (q >= 6) ? 1 : 0;
    const int sq = q - ((l == 3) ? 16 : (l == 2) ? 10 : (l == 1) ? 6 : 0);
    if (l & 1) sub = sq == 0 ? 0 : (sq == 1 ? 3 : (sq == 2 ? 4 : 6));
    else sub = sq <= 4 ? sq : 6;
}
__global__ void __launch_bounds__(NTHREADS, 2) mega_fwd(Args A) {
    extern __shared__ __attribute__((aligned(16))) unsigned char lds_raw[];
    cg::grid_group grid = cg::this_grid();
    Frame F;
    F.lds = (LAS unsigned char*)lds_raw;
    F.tid = threadIdx.x; F.lane = F.tid & 63; F.wave = __builtin_amdgcn_readfirstlane(F.tid >> 6);
    F.G = gridDim.x; F.bid = blockIdx.x;
    F.z = 0; F.out = A.out; F.ws = A.ws;
    volatile LAS unsigned* MISC = (volatile LAS unsigned*)(F.lds + LDSCTL_OFF);
    for (int u = F.tid; u < (LDS_BYTES - LDSCTL_OFF) / 4; u += NTHREADS) ((LAS unsigned*)(F.lds + LDSCTL_OFF))[u] = 0u;
    __syncthreads();
    const int lo = A.ph_lo, hi = A.ph_hi < N_PHASES ? A.ph_hi : N_PHASES;
    XcdBarrier bar; bar.bar = (unsigned*)A.ws + CW_BAR; bar.x = xb_xcc_id(); bar.st = MISC + 8;
    if (blockIdx.x == 0) for (int u = F.tid; u < XCD_BAR_WORDS; u += NTHREADS) ((unsigned*)A.ws + CW_BAR)[u] = 0u;
#pragma unroll 1
    for (int ph = lo; ph < hi; ++ph) {
        { int z = 0; asm volatile("" : "+s"(z)); F.z = z;
          { int b_ = blockIdx.x, g_ = gridDim.x; asm volatile("" : "+s"(b_), "+s"(g_)); F.bid = b_; F.G = g_; }
          int t_ = threadIdx.x; asm volatile("" : "+v"(t_)); F.tid = t_; F.lane = t_ & 63; F.wave = __builtin_amdgcn_readfirstlane(t_ >> 6);
          const char AS4* ka = (const char AS4*)__builtin_amdgcn_kernarg_segment_ptr();
          F.out = *(float* const AS4*)(ka + 192 + z); F.ws = *(unsigned char* const AS4*)(ka + 200 + z); }
        int l, sub; decode_phase(ph, l, sub);
        const int i = l >> 1; const bool ab = (l & 1) == 0;
        if (l < 0) { p0_prologue(A, F); x0_phase(A, F); }
        else if (l == 4) { final_norm_phase(A, F, F.in(9)); }
        else if (sub == 0) {
            if (ab) { const bf16* Bt = F.pWinab() + (size_t)i * NABP * D;
                pg8::Gemm g{F.pXB(), Bt, M, NABP, D}; pg8::StaticOrder S; S.init(M, NABP, F.G, F.bid);
                pg8::EpiBf16N E{F.pRAW(), NABP, F.pSSQ(), (LAS float*)(F.lds + 131072 + 4096), F.lds + 131072 + 5120, F.in(16) + (size_t)i * 128, 8}; pg8::gemm_phase<pg8::EpiBf16N, pg8::StaticOrder, true, true>(F.lds, g, S, E);
            } else { const bf16* Bt = F.pWinc() + (size_t)i * NCC * D;
                pg8::Gemm g{F.pXB(), Bt, MP, NCC, D}; pg8::TripleOrder S; S.init(F.G, F.bid);
                pg8::EpiBf16CX E{F.pRAW(), F.pSSQ(), (LAS float*)(F.lds + 131072 + 4096), F.lds + 131072 + 5120}; pg8::gemm_phase<pg8::EpiBf16CX, pg8::TripleOrder, true, true>(F.lds, g, S, E);
                asm volatile("s_waitcnt vmcnt(0)" ::: "memory"); __syncthreads();
                for (int trip = F.bid; trip < 256; trip += F.G) { int pm, t; pg8::TripleOrder::owner(trip, pm, t); sconv_local_prompt(A, F, i, pm, t); }
                MicroBf16CX Em{F.pRAW(), F.pSSQ()}; micro_phase(F, F.pXB(), Bt, D, NCC, Em);
                for (int c2 = F.bid; c2 < 256; c2 += F.G) sconv_local_sample(A, F, i, c2 & 15, c2 >> 4);
            }
        }
        else if (sub == 4) {
            pg8::Gemm g{F.pXB(), F.pWup() + (size_t)l * NUP * D, M, NUP, D}; pg8::StaticOrder S; S.init(M, NUP, F.G, F.bid);
            pg8::EpiUpAct E{F.pACT(), F.pSSQ(), F.in(22) + (size_t)l * 3 * DFF, F.in(6) + (size_t)l * NS * 2 * DFF, F.out + O_FC_P + (size_t)l * NB * 2 * DFF, F.out + O_FC_S + (size_t)l * NS * 2 * DFF,
                               F.pFIX(), F.pHALO(), (LAS float*)(F.lds + 131072), (LAS float*)(F.lds + 131072 + 4096), F.lds + 131072 + 5120};
            pg8::gemm_phase<pg8::EpiUpAct, pg8::StaticOrder, true, true>(F.lds, g, S, E);
        }
        else if (sub == 3 || sub == 6) {
            const bf16* Am; const bf16* Bt; int K;
            if (sub == 3) { Am = F.pH(); Bt = (ab ? F.pWoutab() : F.pWoutc()) + (size_t)i * D * D; K = D; }
            else { Am = F.pACT(); Bt = F.pWdown() + (size_t)l * D * DFF; K = DFF; }
            pg8::Gemm g{Am, Bt, MP, D, K}; pg8::StaticOrder S; S.init(MP, D, F.G, F.bid);
            if (sub == 6) {
                pg8::Unit uu; for (int k = 0; S.next(k, uu); ++k) if ((uu.pm & 7) != 0) ffn_fix_panel(A, F, l, uu.pm);
                asm volatile("s_waitcnt vmcnt(0)" ::: "memory"); __syncthreads();
            } else if (!ab) {
                pg8::Unit uu; for (int k = 0; S.next(k, uu); ++k) if ((uu.pm & 7) != 0) sconv_fix_panel(A, F, i, uu.pm);
                asm volatile("s_waitcnt vmcnt(0)" ::: "memory"); __syncthreads();
            }
            pg8::EpiResNorm E{F.pXB(), F.pSSQ(), (LAS float*)(F.lds + 131072)}; pg8::gemm_phase<pg8::EpiResNorm, pg8::StaticOrder, true, true>(F.lds, g, S, E);
        }
        else if (sub == 1) {
            for (int r = 0;; ++r) { const int base = (r * F.G + F.bid) * 2; if (base >= 1024) break; const int unit = base + (F.tid >> 8); dnprep_round(A, F, i, unit, unit < 1024); }
        }
        else if (sub == 2) {
            if (F.bid < 32) scan_block(A, F, i, F.bid);
            else { for (int u = F.bid - 32; u < NS * NH; u += F.G - 32) sample_unit(A, F, i, u);
                   for (int u = F.bid - 32; u < 272 * 4; u += F.G - 32) pool_unit(A, F, i, u >> 2, u & 3);
                   convert_weights(A, F, (F.bid - 32) * NWAVES + F.wave, (F.G - 32) * NWAVES, l == 0 ? 1 : 2); }
        }
        if (ph + 1 < hi) { if (ph == lo) { grid.sync(); if (threadIdx.x == 0) (void)xb_add(&bar.bar[XB_XCNT(bar.x)], 1u); } else xcd_barrier(bar); }
    }
}

extern "C" void kernel_launch(void* const* d_in, const int* in_sizes, int n_in, void* d_out, int out_size, void* d_ws, size_t ws_size, hipStream_t stream) {
    static int grid = 0;
    if (grid == 0) {
        int dev = 0, cus = 0, per_cu = 0;
        (void)hipGetDevice(&dev);
        (void)hipDeviceGetAttribute(&cus, hipDeviceAttributeMultiprocessorCount, dev);
        (void)hipFuncSetAttribute((const void*)mega_fwd, hipFuncAttributeMaxDynamicSharedMemorySize, LDS_BYTES);
        (void)hipOccupancyMaxActiveBlocksPerMultiprocessor(&per_cu, (const void*)mega_fwd, NTHREADS, LDS_BYTES);
        (void)hipGetLastError();
        grid = cus;
        if (n_in != 24 || ws_size < WS_END || per_cu < 1) fprintf(stderr, "kernel_launch: n_in %d ws %zu (need %zu) per_cu %d cus %d\n", n_in, ws_size, (size_t)WS_END, per_cu, cus);
    }
    Args a{};
    for (int i = 0; i < 24; ++i) a.in[i] = (const float*)d_in[i];
    a.out = (float*)d_out; a.ws = (unsigned char*)d_ws; a.ph_lo = 0; a.ph_hi = 1000;
    void* kargs[] = {&a};
    hipError_t e = hipLaunchCooperativeKernel((const void*)mega_fwd, dim3(grid), dim3(NTHREADS), kargs, LDS_BYTES, stream);
    if (e != hipSuccess) fprintf(stderr, "cooperative launch failed: %s (grid %d)\n", hipGetErrorString(e), grid);
}
```

```cpp
#include <hip/hip_runtime.h>
#include <hip/hip_cooperative_groups.h>
#include <cstdio>
#include <cstdint>
namespace cg = cooperative_groups;

#define LAS __attribute__((address_space(3)))
#define GAS __attribute__((address_space(1)))
#define DI __device__ __forceinline__

#define XB_TMO      128
#define XB_XCNT(j)  (256  + 64 * (j))
#define XB_XSUB(j)  (1280 + 64 * (j))
#define XB_XGEN(j)  (2304 + 64 * (j))
#define XB_TOP      3328
#define XB_TOPGEN   3392
#define XCD_BAR_WORDS 3456
#define XB_SPIN_CAP (1u << 18)

__device__ __forceinline__ unsigned xb_ld(unsigned* p)              { return __hip_atomic_load(p, __ATOMIC_RELAXED, __HIP_MEMORY_SCOPE_AGENT); }
__device__ __forceinline__ unsigned xb_add(unsigned* p, unsigned v) { return __hip_atomic_fetch_add(p, v, __ATOMIC_RELAXED, __HIP_MEMORY_SCOPE_AGENT); }
__device__ __forceinline__ unsigned xb_xcc_id() { return (unsigned)__builtin_amdgcn_s_getreg((3 << 11) | 20) & 0xFu; }
#define XB_SPIN(cond, bar) do { unsigned _sp = 0; while (cond) { __builtin_amdgcn_s_sleep(1); \
    if ((++_sp & 255u) == 0u) { if (xb_ld(&(bar)[XB_TMO])) break; if (_sp > XB_SPIN_CAP) { atomicAdd(&(bar)[XB_TMO], 1u); break; } } } } while (0)

struct XcdBarrier { unsigned* bar; unsigned x; volatile LAS unsigned* st; };

__device__ __forceinline__ XcdBarrier xcd_barrier_post(unsigned* bar, volatile LAS unsigned* st) {
    XcdBarrier b; b.bar = bar; b.x = xb_xcc_id(); b.st = st;
    if (threadIdx.x == 0) (void)xb_add(&bar[XB_XCNT(b.x)], 1u);
    return b;
}
__device__ __forceinline__ void xcd_barrier_complete(unsigned* bar, unsigned x, unsigned& nloc, unsigned& nx) {
    const unsigned G = gridDim.x * gridDim.y * gridDim.z;
    unsigned sum, cnt, mine, sp = 0u;
    for (;;) {
        sum = 0u; cnt = 0u; mine = 0u;
#pragma unroll
        for (unsigned j = 0; j < 16; ++j) { const unsigned c = xb_ld(&bar[XB_XCNT(j)]); sum += c; cnt += (c > 0u) ? 1u : 0u; mine = (j == x) ? c : mine; }
        if (sum == G) break;
        __builtin_amdgcn_s_sleep(1);
        if ((++sp & 255u) == 0u) { if (xb_ld(&bar[XB_TMO])) break; if (sp > XB_SPIN_CAP) { atomicAdd(&bar[XB_TMO], 1u); break; } }
    }
    nloc = mine > 0u ? mine : 1u; nx = cnt > 0u ? cnt : 1u;
}
__device__ __forceinline__ void xcd_barrier(const XcdBarrier& b) {
    asm volatile("s_waitcnt vmcnt(0)" ::: "memory");
    __syncthreads();
    if (threadIdx.x == 0) {
        unsigned* bar = b.bar;
        __builtin_amdgcn_s_waitcnt(0);
        unsigned nloc = b.st[0], nx = b.st[1];
        if (nloc == 0u) { xcd_barrier_complete(bar, b.x, nloc, nx); b.st[0] = nloc; b.st[1] = nx; }
        const unsigned old = xb_add(&bar[XB_XSUB(b.x)], 1u);
        const unsigned gen = old / nloc;
        if (old + 1u == (gen + 1u) * nloc) {
            __builtin_amdgcn_fence(__ATOMIC_RELEASE, "agent");
            asm volatile("s_waitcnt vmcnt(0)" ::: "memory");
            const unsigned og = xb_add(&bar[XB_TOP], 1u);
            const unsigned tg = og / nx;
            if (og + 1u == (tg + 1u) * nx) xb_add(&bar[XB_TOPGEN], 1u);
            else XB_SPIN(xb_ld(&bar[XB_TOPGEN]) == tg, bar);
            __builtin_amdgcn_fence(__ATOMIC_ACQUIRE, "agent");
            xb_add(&bar[XB_XGEN(b.x)], 1u);
            asm volatile("s_waitcnt vmcnt(0)" ::: "memory");
        } else {
            XB_SPIN(xb_ld(&bar[XB_XGEN(b.x)]) == gen, bar);
            __builtin_amdgcn_fence(__ATOMIC_ACQUIRE, "agent");
            asm volatile("s_waitcnt vmcnt(0)" ::: "memory");
        }
    }
    __syncthreads();
}

namespace pg8 {
#define PG8_LAS __attribute__((address_space(3)))
typedef unsigned short bf16_t;
typedef short bf16x8 __attribute__((ext_vector_type(8)));
typedef float f32x4 __attribute__((ext_vector_type(4)));
typedef unsigned u32x4 __attribute__((ext_vector_type(4)));
constexpr int BM = 256, BK = 64, HALF = 128, HTB = HALF * BK * 2  , STAGE_BYTES = 8 * HTB, NXCD = 8, WGM = 8;

__host__ __device__ __forceinline__ int lds_byte(int r, int c) { const int st = (r >> 4) * 2 + (c >> 5), rr = r & 15, cc = c & 31, ob = rr * 64 + cc * 2; return st * 1024 + (ob ^ (((ob >> 9) & 1) << 5)); }
__host__ __device__ __forceinline__ void stage_rc(int b, int& R, int& C) { const int st = b / 1024, sb = b % 1024, swz = sb ^ (((sb >> 9) & 1) << 5); R = (st >> 1) * 16 + swz / 64; C = (st & 1) * 32 + (swz % 64) / 2; }
__host__ __device__ __forceinline__ int perm32(int rho) { const int n = rho >> 4, i = rho & 15; return 8 * (i >> 2) + 4 * n + (i & 3); }

struct Unit { int pm, pn; };
struct Gemm { const bf16_t* A; const bf16_t* Bt; int M, N, K; };

struct TripleOrder {
    int G, c;
    __device__ __forceinline__ void init(int G_, int c_) { G = G_; c = c_; }
    __device__ __forceinline__ static void owner(int trip, int& pm, int& t) { const int x = trip & 7, slot = trip >> 3; pm = x * 8 + (slot >> 2); t = slot & 3; }
    __device__ __forceinline__ bool next(int i, Unit& u) const {
        const int trip = c + (i / 3) * G; if (trip >= 256) return false;
        int pm, t; owner(trip, pm, t); const int k = i % 3;
        u.pm = pm; u.pn = k == 0 ? t : 4 + 2 * t + (k - 1); return true;
    }
    __device__ __forceinline__ void a_ready(const Unit&) const {}
    __device__ __forceinline__ void done(const Unit&) const {}
};
struct StaticOrder {
    int nM, nN, nwg, G, c;
    __host__ __device__ __forceinline__ void init(int M, int N, int G_, int c_) { nM = M / BM; nN = N / BM; nwg = nM * nN; G = G_; c = c_; }
    __host__ __device__ __forceinline__ bool next(int i, Unit& u) const {
        const long L = (long)i * G + c; if (L >= nwg) return false;
        int wgid = (int)L; { const int q = nwg / NXCD, r = nwg % NXCD, xcd = wgid % NXCD, off = wgid / NXCD; wgid = (xcd < r ? xcd * (q + 1) : r * (q + 1) + (xcd - r) * q) + off; }
        const int nig = WGM * nN, gid = wgid / nig, fm = gid * WGM, gsz = (nM - fm) < WGM ? (nM - fm) : WGM;
        u.pm = fm + ((wgid % nig) % gsz); u.pn = (wgid % nig) / gsz; return true;
    }
    __device__ __forceinline__ void a_ready(const Unit&) const {}
    __device__ __forceinline__ void done(const Unit&) const {}
};

typedef __bf16 bf16x2_t __attribute__((ext_vector_type(2)));
typedef float f32x2_t __attribute__((ext_vector_type(2)));
__device__ __forceinline__ unsigned cvt_pk_bf16(float lo, float hi) { f32x2_t v = {lo, hi}; return __builtin_bit_cast(unsigned, __builtin_convertvector(v, bf16x2_t)); }

struct EpiBf16 {
    static constexpr bool PERM = true, AFTER_DRAIN = false, INIT = false, PREFETCH = false, MICRO = false;
    bf16_t* O; int ldc;
    __device__ __forceinline__ void operator()(const f32x4 (&acc)[2][2][4][2], const Unit& u, int wr, int wc, int fr, int fq) const {
        const int row0 = u.pm * BM + wr * 64 + fr; const int col0 = u.pn * BM + wc * 32 + 8 * fq;
#pragma unroll
        for (int ai = 0; ai < 2; ++ai)
#pragma unroll
            for (int m = 0; m < 4; ++m) { bf16_t* rowp = O + (size_t)(row0 + ai * HALF + m * 16) * ldc + col0;
#pragma unroll
                for (int bj = 0; bj < 2; ++bj) { const f32x4 v0 = acc[ai][bj][m][0], v1 = acc[ai][bj][m][1];
                    u32x4 w; w.x = cvt_pk_bf16(v0[0], v0[1]); w.y = cvt_pk_bf16(v0[2], v0[3]); w.z = cvt_pk_bf16(v1[0], v1[1]); w.w = cvt_pk_bf16(v1[2], v1[3]);
                    *(u32x4*)(rowp + bj * HALF) = w; } }
    }
};
struct EpiResAdd {
    static constexpr bool PERM = false, AFTER_DRAIN = false, INIT = false, PREFETCH = false, MICRO = false;
    float* X; int ldc;
    __device__ __forceinline__ void operator()(const f32x4 (&acc)[2][2][4][2], const Unit& u, int wr, int wc, int fr, int fq) const {
        const int row0 = u.pm * BM + wr * 64 + fr; const int col0 = u.pn * BM + wc * 32 + 4 * fq;
#pragma unroll
        for (int ai = 0; ai < 2; ++ai)
#pragma unroll
            for (int m = 0; m < 4; ++m) { float* rowp = X + (size_t)(row0 + ai * HALF + m * 16) * ldc + col0;
                f32x4 old[2][2];
#pragma unroll
                for (int bj = 0; bj < 2; ++bj)
#pragma unroll
                    for (int n = 0; n < 2; ++n) old[bj][n] = *(const f32x4*)(rowp + bj * HALF + n * 16);
#pragma unroll
                for (int bj = 0; bj < 2; ++bj)
#pragma unroll
                    for (int n = 0; n < 2; ++n) *(f32x4*)(rowp + bj * HALF + n * 16) = old[bj][n] + acc[ai][bj][m][n]; }
    }
};

__device__ __forceinline__ float dpp_ror1(float x) { return __builtin_bit_cast(float, __builtin_amdgcn_update_dpp(0, __builtin_bit_cast(int, x), 0x121, 0xf, 0xf, true)); }
__device__ __forceinline__ float dpp_ror2(float x) { return __builtin_bit_cast(float, __builtin_amdgcn_update_dpp(0, __builtin_bit_cast(int, x), 0x122, 0xf, 0xf, true)); }
__device__ __forceinline__ void conv_dpp(f32x4& a, const f32x4 g, const f32x4 gp, const f32x4 w1, const f32x4 w0) {
    float a0 = a[0], a1 = a[1], a2 = a[2], a3 = a[3];
    asm("s_nop 1\n\t"
        "v_fmac_f32_dpp %0, %4, %12 row_shr:1 row_mask:0xf bank_mask:0xf\n\t"
        "v_fmac_f32_dpp %1, %5, %13 row_shr:1 row_mask:0xf bank_mask:0xf\n\t"
        "v_fmac_f32_dpp %2, %6, %14 row_shr:1 row_mask:0xf bank_mask:0xf\n\t"
        "v_fmac_f32_dpp %3, %7, %15 row_shr:1 row_mask:0xf bank_mask:0xf\n\t"
        "v_fmac_f32_dpp %0, %4, %16 row_shr:2 row_mask:0xf bank_mask:0xf\n\t"
        "v_fmac_f32_dpp %1, %5, %17 row_shr:2 row_mask:0xf bank_mask:0xf\n\t"
        "v_fmac_f32_dpp %2, %6, %18 row_shr:2 row_mask:0xf bank_mask:0xf\n\t"
        "v_fmac_f32_dpp %3, %7, %19 row_shr:2 row_mask:0xf bank_mask:0xf\n\t"
        "v_fmac_f32_dpp %0, %8, %12 row_shl:15 row_mask:0xf bank_mask:0xf\n\t"
        "v_fmac_f32_dpp %1, %9, %13 row_shl:15 row_mask:0xf bank_mask:0xf\n\t"
        "v_fmac_f32_dpp %2, %10, %14 row_shl:15 row_mask:0xf bank_mask:0xf\n\t"
        "v_fmac_f32_dpp %3, %11, %15 row_shl:15 row_mask:0xf bank_mask:0xf\n\t"
        "v_fmac_f32_dpp %0, %8, %16 row_shl:14 row_mask:0xf bank_mask:0xf\n\t"
        "v_fmac_f32_dpp %1, %9, %17 row_shl:14 row_mask:0xf bank_mask:0xf\n\t"
        "v_fmac_f32_dpp %2, %10, %18 row_shl:14 row_mask:0xf bank_mask:0xf\n\t"
        "v_fmac_f32_dpp %3, %11, %19 row_shl:14 row_mask:0xf bank_mask:0xf"
        : "+v"(a0), "+v"(a1), "+v"(a2), "+v"(a3)
        : "v"(g[0]), "v"(g[1]), "v"(g[2]), "v"(g[3]), "v"(gp[0]), "v"(gp[1]), "v"(gp[2]), "v"(gp[3]),
          "v"(w1[0]), "v"(w1[1]), "v"(w1[2]), "v"(w1[3]), "v"(w0[0]), "v"(w0[1]), "v"(w0[2]), "v"(w0[3]));
    a = (f32x4){a0, a1, a2, a3};
}
__device__ __forceinline__ float row_rstd(const float* ssq, int row) {
    const f32x4 a = *(const f32x4*)(ssq + (size_t)row * 16), b = *(const f32x4*)(ssq + (size_t)row * 16 + 4), c = *(const f32x4*)(ssq + (size_t)row * 16 + 8), d = *(const f32x4*)(ssq + (size_t)row * 16 + 12);
    const float s = ((a[0] + a[1]) + (a[2] + a[3])) + ((b[0] + b[1]) + (b[2] + b[3])) + ((c[0] + c[1]) + (c[2] + c[3])) + ((d[0] + d[1]) + (d[2] + d[3]));
    return rsqrtf(s * (1.0f / 1024.0f) + 1e-6f);
}
__device__ __forceinline__ void ssq_prefetch(const bf16_t* ssq, int pm, PG8_LAS unsigned char* blk) {
    int t = threadIdx.x; asm volatile("" : "+v"(t)); const int w = __builtin_amdgcn_readfirstlane(t >> 6);
    const bf16_t* src = ssq + (size_t)pm * BM * 32 + (size_t)t * 8;
    __builtin_amdgcn_global_load_lds((const unsigned*)src, (PG8_LAS unsigned*)(blk + w * 1024), 16, 0, 0);
    __builtin_amdgcn_global_load_lds((const unsigned*)(src + 4096), (PG8_LAS unsigned*)(blk + 8192 + w * 1024), 16, 0, 0);
}
__device__ __forceinline__ void rstd_table_fill(const PG8_LAS unsigned char* blk, PG8_LAS float* tab) {
    int t = threadIdx.x; asm volatile("" : "+v"(t)); const int row = t >> 1, hf = t & 1;
    const u32x4 a = *(const PG8_LAS u32x4*)(blk + row * 64 + 32 * hf), b = *(const PG8_LAS u32x4*)(blk + row * 64 + 32 * hf + 16);
    float s = 0.f;
#pragma unroll
    for (int e = 0; e < 4; ++e) { s += __uint_as_float(a[e] << 16) + __uint_as_float(a[e] & 0xffff0000u); s += __uint_as_float(b[e] << 16) + __uint_as_float(b[e] & 0xffff0000u); }
    s += __shfl_xor(s, 1);
    if (hf == 0) tab[row] = rsqrtf(s * (1.0f / 1024.0f) + 1e-6f);
}
struct EpiBf16CX {
    static constexpr bool PERM = true, AFTER_DRAIN = false, INIT = false, PREFETCH = true, MICRO = false;
    static constexpr int LDC = 2048;
    bf16_t* O; const bf16_t* ssq; PG8_LAS float* tab; PG8_LAS unsigned char* blk;
    __device__ __forceinline__ void prefetch(const Unit& u) const { ssq_prefetch(ssq, u.pm, blk); }
    __device__ __forceinline__ void operator()(const f32x4 (&acc)[2][2][4][2], const Unit& u, int wr, int wc, int fr, int fq) const {
        rstd_table_fill(blk, tab);
        asm volatile("s_waitcnt lgkmcnt(0)" ::: "memory"); __builtin_amdgcn_s_barrier(); asm volatile("" ::: "memory");
        const int row0 = u.pm * BM + wr * 64 + fr;
        if (u.pn < 4) {
            const int col0 = u.pn * BM + wc * 32 + 8 * fq;
#pragma unroll
            for (int ai = 0; ai < 2; ++ai)
#pragma unroll
                for (int m = 0; m < 4; ++m) { const int row = row0 + ai * HALF + m * 16; const float rs = tab[ai * HALF + wr * 64 + m * 16 + fr]; bf16_t* rowp = O + (size_t)row * LDC + col0;
#pragma unroll
                    for (int bj = 0; bj < 2; ++bj) { const f32x4 v0 = acc[ai][bj][m][0] * rs, v1 = acc[ai][bj][m][1] * rs;
                        u32x4 w; w.x = cvt_pk_bf16(v0[0], v0[1]); w.y = cvt_pk_bf16(v0[2], v0[3]); w.z = cvt_pk_bf16(v1[0], v1[1]); w.w = cvt_pk_bf16(v1[2], v1[3]);
                        *(u32x4*)(rowp + bj * HALF) = w; } }
        } else {
            const int col0 = 1024 + (u.pn - 4) * HALF + wc * 32 + 8 * fq;
#pragma unroll
            for (int ai = 0; ai < 2; ++ai)
#pragma unroll
                for (int m = 0; m < 4; ++m) { const int row = row0 + ai * HALF + m * 16; const float rs = tab[ai * HALF + wr * 64 + m * 16 + fr]; const float r2 = rs * rs;
                    const f32x4 v0 = acc[ai][0][m][0] * acc[ai][1][m][0] * r2, v1 = acc[ai][0][m][1] * acc[ai][1][m][1] * r2;
                    u32x4 w; w.x = cvt_pk_bf16(v0[0], v0[1]); w.y = cvt_pk_bf16(v0[2], v0[3]); w.z = cvt_pk_bf16(v1[0], v1[1]); w.w = cvt_pk_bf16(v1[2], v1[3]);
                    *(u32x4*)(O + (size_t)row * LDC + col0) = w; }
        }
    }
};
struct EpiBf16N {
    static constexpr bool PERM = true, AFTER_DRAIN = false, INIT = false, PREFETCH = true, MICRO = false;
    bf16_t* O; int ldc; const bf16_t* ssq; PG8_LAS float* tab; PG8_LAS unsigned char* blk;
    const float* znw; int zpn;
    __device__ __forceinline__ void prefetch(const Unit& u) const { ssq_prefetch(ssq, u.pm, blk); }
    __device__ __forceinline__ void operator()(const f32x4 (&acc)[2][2][4][2], const Unit& u, int wr, int wc, int fr, int fq) const {
        if ((u.pn == zpn) || (u.pn == zpn + 1)) run<true>(acc, u, wr, wc, fr, fq); else run<false>(acc, u, wr, wc, fr, fq); }
    template <bool zt>
    __device__ __forceinline__ void run(const f32x4 (&acc)[2][2][4][2], const Unit& u, int wr, int wc, int fr, int fq) const {
        f32x4 nw0 = {1.f, 1.f, 1.f, 1.f}, nw1 = nw0;
        if constexpr (zt) { nw0 = *(const f32x4*)(znw + wc * 32 + 8 * fq); nw1 = *(const f32x4*)(znw + wc * 32 + 8 * fq + 4); }
        rstd_table_fill(blk, tab);
        asm volatile("s_waitcnt lgkmcnt(0)" ::: "memory"); __builtin_amdgcn_s_barrier(); asm volatile("" ::: "memory");
        const int row0 = u.pm * BM + wr * 64 + fr; const int col0 = u.pn * BM + wc * 32 + 8 * fq;
#pragma unroll
        for (int ai = 0; ai < 2; ++ai)
#pragma unroll
            for (int m = 0; m < 4; ++m) { const int row = row0 + ai * HALF + m * 16; const float rs = tab[ai * HALF + wr * 64 + m * 16 + fr]; bf16_t* rowp = O + (size_t)row * ldc + col0;
#pragma unroll
                for (int bj = 0; bj < 2; ++bj) { f32x4 v0 = acc[ai][bj][m][0] * rs, v1 = acc[ai][bj][m][1] * rs;
                    if constexpr (zt) {
#pragma unroll
                        for (int j = 0; j < 4; ++j) { v0[j] = v0[j] * __builtin_amdgcn_rcpf(1.f + __builtin_amdgcn_exp2f(-1.4426950408889634f * v0[j])); v1[j] = v1[j] * __builtin_amdgcn_rcpf(1.f + __builtin_amdgcn_exp2f(-1.4426950408889634f * v1[j])); }
                        v0 = v0 * nw0; v1 = v1 * nw1; }
                    u32x4 w; w.x = cvt_pk_bf16(v0[0], v0[1]); w.y = cvt_pk_bf16(v0[2], v0[3]); w.z = cvt_pk_bf16(v1[0], v1[1]); w.w = cvt_pk_bf16(v1[2], v1[3]);
                    *(u32x4*)(rowp + bj * HALF) = w; } }
    }
};
struct EpiResNorm {
    static constexpr bool PERM = true, AFTER_DRAIN = false, INIT = true, PREFETCH = false, MICRO = true;
    bf16_t* XB; bf16_t* SSQ; PG8_LAS float* rsx;
    static __device__ __forceinline__ int xslot(int s_) { return 131072 + 1024 + s_ * 8192; }
    __device__ __forceinline__ void micro_epilogue(const f32x4 (&as)[2], const Unit& u, int wr, int wc, int fr, int fq) const {
        asm volatile("" : "+v"(fr), "+v"(fq));
        const int bjs = u.pm >> 5, row = 16384 + 32 * (u.pm & 31) + 16 * wr + fr;
        bf16_t* p = XB + (size_t)row * 1024 + u.pn * BM + bjs * HALF + wc * 32 + 8 * fq;
        const u32x4 o = *(const u32x4*)p;
        const float t0 = __uint_as_float(o.x << 16) + as[0][0], t1 = __uint_as_float(o.x & 0xffff0000u) + as[0][1], t2 = __uint_as_float(o.y << 16) + as[0][2], t3 = __uint_as_float(o.y & 0xffff0000u) + as[0][3];
        const float t4 = __uint_as_float(o.z << 16) + as[1][0], t5 = __uint_as_float(o.z & 0xffff0000u) + as[1][1], t6 = __uint_as_float(o.w << 16) + as[1][2], t7 = __uint_as_float(o.w & 0xffff0000u) + as[1][3];
        float sq = ((t0 * t0 + t1 * t1) + (t2 * t2 + t3 * t3)) + ((t4 * t4 + t5 * t5) + (t6 * t6 + t7 * t7));
        u32x4 w; w.x = cvt_pk_bf16(t0, t1); w.y = cvt_pk_bf16(t2, t3); w.z = cvt_pk_bf16(t4, t5); w.w = cvt_pk_bf16(t6, t7); *(u32x4*)p = w;
        sq += __shfl_xor(sq, 16); sq += __shfl_xor(sq, 32);
        if (fq == 0) rsx[(wr * 16 + fr) * 4 + wc] = sq;
        asm volatile("s_waitcnt lgkmcnt(0)" ::: "memory"); __builtin_amdgcn_s_barrier(); asm volatile("" ::: "memory");
        if (wc == 0 && fq == 0) { const f32x4 q4 = *(const PG8_LAS f32x4*)(rsx + (wr * 16 + fr) * 4);
            *(unsigned long long*)(SSQ + (size_t)row * 32 + 8 * u.pn + 4 * bjs) = (unsigned long long)cvt_pk_bf16((q4[0] + q4[1]) + (q4[2] + q4[3]), 0.f); }
    }
    __device__ __forceinline__ void init(f32x4 (&acc)[2][2][4][2], const Unit& u, int wr, int wc, int fr, int fq) const {
        const int row0 = u.pm * BM + wr * 64 + fr; const int col0 = u.pn * BM + wc * 32 + 8 * fq;
#pragma unroll
        for (int ai = 0; ai < 2; ++ai)
#pragma unroll
            for (int m = 0; m < 4; ++m)
#pragma unroll
                for (int bj = 0; bj < 2; ++bj) { const u32x4 o = *(const u32x4*)(XB + (size_t)(row0 + ai * HALF + m * 16) * 1024 + col0 + bj * HALF);
                    acc[ai][bj][m][0] = (f32x4){__uint_as_float(o.x << 16), __uint_as_float(o.x & 0xffff0000u), __uint_as_float(o.y << 16), __uint_as_float(o.y & 0xffff0000u)};
                    acc[ai][bj][m][1] = (f32x4){__uint_as_float(o.z << 16), __uint_as_float(o.z & 0xffff0000u), __uint_as_float(o.w << 16), __uint_as_float(o.w & 0xffff0000u)}; }
    }
    __device__ __forceinline__ void operator()(const f32x4 (&acc)[2][2][4][2], const Unit& u, int wr, int wc, int fr, int fq) const {
        asm volatile("" : "+v"(fr), "+v"(fq));
        const int row0 = u.pm * BM + wr * 64 + fr; const int col0 = u.pn * BM + wc * 32 + 8 * fq;
#pragma unroll
        for (int ai = 0; ai < 2; ++ai)
#pragma unroll
            for (int m = 0; m < 4; ++m) { const int row = row0 + ai * HALF + m * 16; bf16_t* rowb = XB + (size_t)row * 1024 + col0;
                float s[2];
#pragma unroll
                for (int bj = 0; bj < 2; ++bj) { const f32x4 a0 = acc[ai][bj][m][0], a1 = acc[ai][bj][m][1];
                    s[bj] = ((a0[0] * a0[0] + a0[1] * a0[1]) + (a0[2] * a0[2] + a0[3] * a0[3])) + ((a1[0] * a1[0] + a1[1] * a1[1]) + (a1[2] * a1[2] + a1[3] * a1[3]));
                    u32x4 w; w.x = cvt_pk_bf16(a0[0], a0[1]); w.y = cvt_pk_bf16(a0[2], a0[3]); w.z = cvt_pk_bf16(a1[0], a1[1]); w.w = cvt_pk_bf16(a1[2], a1[3]); *(u32x4*)(rowb + bj * HALF) = w; }
#pragma unroll
                for (int bj = 0; bj < 2; ++bj) { s[bj] += __shfl_xor(s[bj], 16); s[bj] += __shfl_xor(s[bj], 32); }
                if (fq == 0) { SSQ[(size_t)row * 32 + 8 * u.pn + wc] = (bf16_t)(cvt_pk_bf16(s[0], 0.f) & 0xffffu); SSQ[(size_t)row * 32 + 8 * u.pn + 4 + wc] = (bf16_t)(cvt_pk_bf16(s[1], 0.f) & 0xffffu); } }
    }
};
struct EpiUpAct {
    static constexpr bool PERM = true, AFTER_DRAIN = false, INIT = false, PREFETCH = true, MICRO = false;
    bf16_t* ACT; const bf16_t* ssq; const float* cw; const float* st; float* fc_p; float* fc_s; float* FIX; float* HALO; PG8_LAS float* hx; PG8_LAS float* tab; PG8_LAS unsigned char* blk;
    __device__ __forceinline__ void prefetch(const Unit& u) const { ssq_prefetch(ssq, u.pm, blk); }
    __device__ __forceinline__ void operator()(f32x4 (&acc)[2][2][4][2], const Unit& u, int wr, int wc, int fr, int fq) const {
        if (u.pm >= 64) run<true>(acc, u, wr, wc, fr, fq); else run<false>(acc, u, wr, wc, fr, fq); }
    template <bool sample>
    __device__ __forceinline__ void run(f32x4 (&acc)[2][2][4][2], const Unit& u, int wr, int wc, int fr, int fq) const {
        constexpr int FF = 2816;
        asm volatile("" : "+v"(fr), "+v"(fq));
        const int pmod = u.pm & 7;
        const int L0 = 128 * u.pn + 32 * wc + 8 * fq;
        f32x4 w0[2], w1[2], w2[2];
#pragma unroll
        for (int n = 0; n < 2; ++n) { w0[n] = *(const f32x4*)(cw + L0 + 4 * n); w1[n] = *(const f32x4*)(cw + FF + L0 + 4 * n); w2[n] = *(const f32x4*)(cw + 2 * FF + L0 + 4 * n); }
        rstd_table_fill(blk, tab);
        if (fr >= 14) {
#pragma unroll
            for (int ai = 0; ai < 2; ++ai)
#pragma unroll
                for (int n = 0; n < 2; ++n) *(PG8_LAS f32x4*)(hx + ((((ai * 2 + wr) * 4 + wc) * 2 + (fr - 14)) * 32 + fq * 8 + n * 4)) = acc[ai][0][3][n];
        }
        asm volatile("s_waitcnt lgkmcnt(0)" ::: "memory"); __builtin_amdgcn_s_barrier(); asm volatile("" ::: "memory");
        const int tau = fr & 7;
        f32x4 c1[2], c2[2];
        auto ldstate = [&](int ai_, int m_, f32x4 (&q1)[2], f32x4 (&q2)[2]) {
            const int s = (u.pm * BM + ai_ * HALF + wr * 64 + m_ * 16 + fr - 16384) >> 3; const float* sp = st + (size_t)s * 2 * FF + L0;
#pragma unroll
            for (int n = 0; n < 2; ++n) { q1[n] = *(const f32x4*)(sp + FF + 4 * n); q2[n] = *(const f32x4*)(sp + 4 * n); } };
        if constexpr (sample) ldstate(0, 0, c1, c2);
#pragma unroll
        for (int ai = 0; ai < 2; ++ai) {
            float rs[4];
#pragma unroll
            for (int m = 0; m < 4; ++m) rs[m] = tab[ai * HALF + wr * 64 + m * 16 + fr];
            f32x4 gp[2] = {{0.f, 0.f, 0.f, 0.f}, {0.f, 0.f, 0.f, 0.f}};
            if (!(ai == 0 && wr == 0)) { const int as = wr == 1 ? ai : 0, ws = wr == 1 ? 0 : 1;
                const PG8_LAS float* hp = hx + (((as * 2 + ws) * 4 + wc) * 2) * 32 + fq * 8;
                const int rb = as * HALF + ws * 64 + 48;
                if (fr >= 14) { const float sc = tab[rb + fr]; gp[0] = *(const PG8_LAS f32x4*)(hp + (fr - 14) * 32) * sc; gp[1] = *(const PG8_LAS f32x4*)(hp + (fr - 14) * 32 + 4) * sc; } }
#pragma unroll
            for (int m = 0; m < 4; ++m) {
                const int rt = ai * HALF + wr * 64 + m * 16 + fr, row = u.pm * BM + rt;
                f32x4 n1[2], n2[2];
                if constexpr (sample) { if (!(ai == 1 && m == 3)) ldstate(m == 3 ? ai + 1 : ai, m == 3 ? 0 : m + 1, n1, n2); }
                u32x4 ow;
#pragma unroll
                for (int n = 0; n < 2; ++n) {
                    const int L = L0 + 4 * n;
                    const f32x4 g = acc[ai][0][m][n] * rs[m], v = acc[ai][1][m][n] * rs[m];
                    f32x4 a;
                    if constexpr (sample) {
                        f32x4 p1, p2;
#pragma unroll
                        for (int j = 0; j < 4; ++j) { const float h1 = fr == 15 ? gp[n][j] : g[j], h2 = fr >= 14 ? gp[n][j] : g[j]; p1[j] = dpp_ror1(h1); p2[j] = dpp_ror2(h2); }
                        const int s = (row - 16384) >> 3;
#pragma unroll
                        for (int j = 0; j < 4; ++j) { p2[j] = tau == 0 ? c2[n][j] : (tau == 1 ? c1[n][j] : p2[j]); p1[j] = tau == 0 ? c1[n][j] : p1[j]; }
                        if (tau >= 6) *(f32x4*)(fc_s + ((size_t)s * 2 + (tau - 6)) * FF + L) = g;
                        a = w0[n] * p2 + w1[n] * p1 + w2[n] * g;
                    } else {
                        if (ai == 0 && m == 0) { if (rt < 2 && pmod != 0) { float* fx = FIX + ((size_t)(u.pm * 2 + rt) * 2) * FF + L; *(f32x4*)fx = g; *(f32x4*)(fx + FF) = v; } }
                        if (ai == 1 && m == 3) { if (rt >= 254) { if (pmod != 7) *(f32x4*)(HALO + ((size_t)u.pm * 2 + (rt - 254)) * FF + L) = g;
                                                                  else *(f32x4*)(fc_p + ((size_t)(u.pm >> 3) * 2 + (rt - 254)) * FF + L) = g; } }
                        a = w2[n] * g; conv_dpp(a, g, gp[n], w1[n], w0[n]);
                    }
                    const f32x4 t = a * (f32x4){-1.4426950408889634f, -1.4426950408889634f, -1.4426950408889634f, -1.4426950408889634f};
                    f32x4 d = {__builtin_amdgcn_exp2f(t[0]), __builtin_amdgcn_exp2f(t[1]), __builtin_amdgcn_exp2f(t[2]), __builtin_amdgcn_exp2f(t[3])};
                    d = d + (f32x4){1.f, 1.f, 1.f, 1.f};
                    const f32x4 r = {__builtin_amdgcn_rcpf(d[0]), __builtin_amdgcn_rcpf(d[1]), __builtin_amdgcn_rcpf(d[2]), __builtin_amdgcn_rcpf(d[3])};
                    const f32x4 o = a * r * v;
                    if (n == 0) { ow.x = cvt_pk_bf16(o[0], o[1]); ow.y = cvt_pk_bf16(o[2], o[3]); } else { ow.z = cvt_pk_bf16(o[0], o[1]); ow.w = cvt_pk_bf16(o[2], o[3]); }
                    gp[n] = g;
                }
                *(u32x4*)(ACT + (size_t)row * FF + L0) = ow;
                asm volatile("" ::: "memory");
                if constexpr (sample) { if (!(ai == 1 && m == 3)) {
#pragma unroll
                    for (int n = 0; n < 2; ++n) { c1[n] = n1[n]; c2[n] = n2[n]; } } }
            }
        }
    }
};

template <class Epi, class Sched, bool ALIGN_EPI = false, bool SP2 = false>
__device__ __forceinline__ void gemm_phase(PG8_LAS unsigned char* lds, const Gemm g, const Sched& S, const Epi& E) {
    int tid = threadIdx.x; asm volatile("" : "+v"(tid));
    const int wid = __builtin_amdgcn_readfirstlane(tid >> 6), lane = tid & 63, wr = wid >> 2, wc = wid & 3, fr = lane & 15, fq = lane >> 4;
    const int K = g.K, nt = K / BK;
    unsigned voffA[2], voffB[2];
#pragma unroll
    for (int i = 0; i < 2; ++i) { int R, C; stage_rc(tid * 16 + i * 8192, R, C); const int Rb = Epi::PERM ? ((R & ~31) + perm32(R & 31)) : R;
        voffA[i] = (unsigned)(R * K + C) * 2u; voffB[i] = (unsigned)(Rb * K + C) * 2u; }
    const size_t kstep = (size_t)(BK * 2);
    const size_t hstep = (size_t)HALF * K * 2;
    const size_t tstep = 2 * hstep;
    const unsigned ldsw = (unsigned)wid * 1024u;
    const int aoff = lds_byte(wr * 64 + fr, fq * 8), boff = lds_byte(wc * 32 + fr, fq * 8);
#define PG8_SA(b, h) (((b) * 2 + (h)) * HTB)
#define PG8_SB(b, h) ((4 + (b) * 2 + (h)) * HTB)
#define PG8_STAGE(bufoff, gbase, voff) do { _Pragma("unroll") for (int _i = 0; _i < 2; ++_i) \
        __builtin_amdgcn_global_load_lds((const unsigned*)((const char*)(gbase) + (voff)[_i]), (PG8_LAS unsigned*)(lds + (bufoff) + ldsw + _i * 8192), 16, 0, 0); } while (0)
#define PG8_LDA(dst, b, h) do { _Pragma("unroll") for (int m = 0; m < 4; ++m) _Pragma("unroll") for (int k = 0; k < 2; ++k) dst[m][k] = *(const PG8_LAS bf16x8*)(lds + PG8_SA(b, h) + aoff + m * 2048 + k * 1024); } while (0)
#define PG8_LDB(dst, b, h) do { _Pragma("unroll") for (int n = 0; n < 2; ++n) _Pragma("unroll") for (int k = 0; k < 2; ++k) dst[n][k] = *(const PG8_LAS bf16x8*)(lds + PG8_SB(b, h) + boff + n * 2048 + k * 1024); } while (0)
#define PG8_MMA(ai, bj, At, Bt) do { __builtin_amdgcn_s_setprio(1); _Pragma("unroll") for (int m = 0; m < 4; ++m) _Pragma("unroll") for (int n = 0; n < 2; ++n) _Pragma("unroll") for (int k = 0; k < 2; ++k) \
        acc[ai][bj][m][n] = __builtin_amdgcn_mfma_f32_16x16x32_bf16(Bt[n][k], At[m][k], acc[ai][bj][m][n], 0, 0, 0); __builtin_amdgcn_s_setprio(0); } while (0)
#define PG8_WAIT_V(n) asm volatile("s_waitcnt vmcnt(" #n ")" ::: "memory")
#define PG8_WAIT_L(n) asm volatile("s_waitcnt lgkmcnt(" #n ")" ::: "memory")
#define PG8_BAR __builtin_amdgcn_s_barrier()
#define PG8_SCHED __builtin_amdgcn_sched_barrier(0)
    Unit cur, nxt; int ui = 0;
    if (!S.next(0, cur)) return;
    f32x4 acc[2][2][4][2];
    if constexpr (Epi::PREFETCH) E.prefetch(cur);
    if constexpr (Epi::INIT) E.init(acc, cur, wr, wc, fr, fq);
    else {
#pragma unroll
    for (int a = 0; a < 2; ++a)
#pragma unroll
        for (int b = 0; b < 2; ++b)
#pragma unroll
            for (int m = 0; m < 4; ++m)
#pragma unroll
                for (int n = 0; n < 2; ++n) acc[a][b][m][n] = (f32x4){0.f, 0.f, 0.f, 0.f};
    }
    bf16x8 At[4][2], B0[2][2], B1[2][2];
    f32x4 acc_s[2]; int mq = 0, xb = 0; unsigned xso = 0u, xro0 = 0u;
    PG8_LAS unsigned char* const xbase = lds + 131072 + 1024;
#define PG8_MICRO_STAGE(kt) do { __builtin_amdgcn_global_load_lds((const unsigned*)((const char*)g.A + (size_t)(kt) * (BK * 2) + xso), (PG8_LAS unsigned*)(xbase + xb * 8192 + wid * 1024), 16, 0, 0); xb = xb == 2 ? 0 : xb + 1; } while (0)
#define PG8_MICRO_SETUP(u_) do { if constexpr (Epi::MICRO) { mq = (u_).pm >> 5; \
        { const int p_ = tid & 511, r_ = (p_ >> 3) & 31, s_ = p_ & 7; xso = (unsigned)((16384 + 32 * ((u_).pm & 31) + r_) * K + 8 * (s_ ^ (r_ & 7))) * 2u; } \
        xro0 = (unsigned)((16 * wr + fr) * 128 + ((fq ^ (fr & 7)) << 4));   \
        acc_s[0] = (f32x4){0.f, 0.f, 0.f, 0.f}; acc_s[1] = acc_s[0]; xb = 0; } } while (0)
#define PG8_MICRO_MMA1(Bf, slot) do { At[0][0] = *(const PG8_LAS bf16x8*)(xbase + (slot) * 8192 + xro0); At[0][1] = *(const PG8_LAS bf16x8*)(xbase + (slot) * 8192 + (xro0 ^ 64u)); \
        _Pragma("unroll") for (int n_ = 0; n_ < 2; ++n_) _Pragma("unroll") for (int k_ = 0; k_ < 2; ++k_) acc_s[n_] = __builtin_amdgcn_mfma_f32_16x16x32_bf16(Bf[n_][k_], At[0][k_], acc_s[n_], 0, 0, 0); } while (0)
#define PG8_MMA_SP2_MICRO(slot) do { __builtin_amdgcn_s_setprio(1); \
        _Pragma("unroll") for (int m = 0; m < 4; ++m) { \
            _Pragma("unroll") for (int n = 0; n < 2; ++n) _Pragma("unroll") for (int k = 0; k < 2; ++k) { \
                acc[1][0][m][n] = __builtin_amdgcn_mfma_f32_16x16x32_bf16(B0[n][k], At[m][k], acc[1][0][m][n], 0, 0, 0); \
                acc[1][1][m][n] = __builtin_amdgcn_mfma_f32_16x16x32_bf16(B1[n][k], At[m][k], acc[1][1][m][n], 0, 0, 0); } \
            if (m == 0) { At[0][0] = *(const PG8_LAS bf16x8*)(lds + Epi::xslot(slot) + xro0); At[0][1] = *(const PG8_LAS bf16x8*)(lds + Epi::xslot(slot) + (xro0 ^ 64u)); } } \
        if (mq == 0) { _Pragma("unroll") for (int n_ = 0; n_ < 2; ++n_) _Pragma("unroll") for (int k_ = 0; k_ < 2; ++k_) acc_s[n_] = __builtin_amdgcn_mfma_f32_16x16x32_bf16(B0[n_][k_], At[0][k_], acc_s[n_], 0, 0, 0); } \
        else { _Pragma("unroll") for (int n_ = 0; n_ < 2; ++n_) _Pragma("unroll") for (int k_ = 0; k_ < 2; ++k_) acc_s[n_] = __builtin_amdgcn_mfma_f32_16x16x32_bf16(B1[n_][k_], At[0][k_], acc_s[n_], 0, 0, 0); } \
        __builtin_amdgcn_s_setprio(0); } while (0)
#define PG8_MICRO_MMA(slot) do { if constexpr (Epi::MICRO) { if (mq == 0) PG8_MICRO_MMA1(B0, slot); else PG8_MICRO_MMA1(B1, slot); } } while (0)
#define PG8_WAIT_VM(n, nm) do { if constexpr (Epi::MICRO) PG8_WAIT_V(nm); else PG8_WAIT_V(n); } while (0)
    const char* cA = (const char*)g.A + (size_t)cur.pm * tstep; const char* cB = (const char*)g.Bt + (size_t)cur.pn * tstep;
    S.a_ready(cur);
    PG8_MICRO_SETUP(cur);
    int xrd = 0;
    if constexpr (Epi::MICRO) PG8_MICRO_STAGE(0);
    if constexpr (SP2) {
        PG8_STAGE(PG8_SB(0, 0), cB, voffB); PG8_STAGE(PG8_SB(0, 1), cB + hstep, voffB); PG8_STAGE(PG8_SA(0, 0), cA, voffA); PG8_STAGE(PG8_SA(0, 1), cA + hstep, voffA);
        if (wr == 1) PG8_BAR;
        PG8_WAIT_V(2); PG8_BAR;
        PG8_STAGE(PG8_SB(1, 0), cB + kstep, voffB); PG8_STAGE(PG8_SA(1, 0), cA + kstep, voffA); PG8_STAGE(PG8_SB(1, 1), cB + hstep + kstep, voffB);
        PG8_WAIT_V(6); PG8_BAR;
    } else {
        PG8_STAGE(PG8_SB(0, 0), cB, voffB); PG8_STAGE(PG8_SA(0, 0), cA, voffA); PG8_STAGE(PG8_SB(0, 1), cB + hstep, voffB); PG8_STAGE(PG8_SA(0, 1), cA + hstep, voffA);
        if (wr == 1) PG8_BAR;
        PG8_WAIT_V(4); PG8_BAR;
        PG8_STAGE(PG8_SB(1, 0), cB + kstep, voffB); PG8_STAGE(PG8_SA(1, 0), cA + kstep, voffA); PG8_STAGE(PG8_SB(1, 1), cB + hstep + kstep, voffB);
        PG8_WAIT_V(6); PG8_BAR;
    }
    for (;;) {
        const bool has_next = S.next(ui + 1, nxt);
        const char* nA = has_next ? (const char*)g.A + (size_t)nxt.pm * tstep : cA; const char* nB = has_next ? (const char*)g.Bt + (size_t)nxt.pn * tstep : cB;
        for (int t = 0; t < nt; t += 2) {
            const bool last = (t == nt - 2);
            const char* a1 = cA + (size_t)(t + 1) * kstep;
            const char* a2 = last ? nA : cA + (size_t)(t + 2) * kstep; const char* b2 = last ? nB : cB + (size_t)(t + 2) * kstep;
            const char* a3 = a2 + kstep; const char* b3 = b2 + kstep;
            if (last && has_next) S.a_ready(nxt);
            if constexpr (SP2) {
            PG8_LDB(B0, 0, 0); PG8_LDB(B1, 0, 1); PG8_SCHED; PG8_LDA(At, 0, 0); PG8_STAGE(PG8_SA(1, 1), a1 + hstep, voffA);
            if constexpr (Epi::MICRO) PG8_MICRO_STAGE(t + 1);
            PG8_WAIT_VM(8, 9); PG8_WAIT_L(0); PG8_BAR; PG8_MMA(0, 0, At, B0); PG8_MMA(0, 1, At, B1); PG8_BAR; PG8_SCHED;
            PG8_LDA(At, 0, 1); PG8_STAGE(PG8_SB(0, 0), b2, voffB); PG8_STAGE(PG8_SB(0, 1), b2 + hstep, voffB); PG8_STAGE(PG8_SA(0, 0), a2, voffA);
            PG8_WAIT_VM(8, 9); PG8_WAIT_L(0); PG8_BAR;
            if constexpr (Epi::MICRO) { PG8_MMA_SP2_MICRO(xrd); xrd = xrd == 2 ? 0 : xrd + 1; }
            else { PG8_MMA(1, 0, At, B0); PG8_MMA(1, 1, At, B1); }
            PG8_BAR; PG8_SCHED;
            PG8_LDB(B0, 1, 0); PG8_LDB(B1, 1, 1); PG8_SCHED; PG8_LDA(At, 1, 0); PG8_STAGE(PG8_SA(0, 1), a2 + hstep, voffA);
            if constexpr (Epi::MICRO) PG8_MICRO_STAGE(t + 2 < nt ? t + 2 : t + 1);
            PG8_WAIT_VM(8, 9); PG8_WAIT_L(0); PG8_BAR; PG8_MMA(0, 0, At, B0); PG8_MMA(0, 1, At, B1); PG8_BAR; PG8_SCHED;
            PG8_LDA(At, 1, 1); PG8_STAGE(PG8_SB(1, 0), b3, voffB); PG8_STAGE(PG8_SB(1, 1), b3 + hstep, voffB); PG8_STAGE(PG8_SA(1, 0), a3, voffA);
            PG8_WAIT_VM(8, 9); PG8_WAIT_L(0); PG8_BAR;
            if constexpr (Epi::MICRO) { PG8_MMA_SP2_MICRO(xrd); xrd = xrd == 2 ? 0 : xrd + 1; }
            else { PG8_MMA(1, 0, At, B0); PG8_MMA(1, 1, At, B1); }
            PG8_BAR; PG8_SCHED;
            } else {
            PG8_LDB(B0, 0, 0); PG8_SCHED; PG8_LDA(At, 0, 0); PG8_STAGE(PG8_SA(1, 1), a1 + hstep, voffA);
            PG8_WAIT_L(8); PG8_BAR; PG8_WAIT_L(0); PG8_MMA(0, 0, At, B0); PG8_BAR; PG8_SCHED;
            PG8_LDB(B1, 0, 1); PG8_STAGE(PG8_SB(0, 0), b2, voffB);
            PG8_BAR; PG8_WAIT_L(0); PG8_MMA(0, 1, At, B1); PG8_BAR;
            PG8_LDA(At, 0, 1); PG8_STAGE(PG8_SA(0, 0), a2, voffA);
            PG8_BAR; PG8_WAIT_L(0); PG8_MMA(1, 0, At, B0); PG8_BAR; PG8_SCHED;
            PG8_STAGE(PG8_SB(0, 1), b2 + hstep, voffB);
            PG8_WAIT_V(6); PG8_BAR; PG8_MMA(1, 1, At, B1); PG8_BAR;
            PG8_LDB(B0, 1, 0); PG8_SCHED; PG8_LDA(At, 1, 0); PG8_STAGE(PG8_SA(0, 1), a2 + hstep, voffA);
            PG8_WAIT_L(8); PG8_BAR; PG8_WAIT_L(0); PG8_MMA(0, 0, At, B0); PG8_BAR; PG8_SCHED;
            PG8_LDB(B1, 1, 1); PG8_STAGE(PG8_SB(1, 0), b3, voffB);
            PG8_BAR; PG8_WAIT_L(0); PG8_MMA(0, 1, At, B1); PG8_BAR;
            PG8_LDA(At, 1, 1); PG8_STAGE(PG8_SA(1, 0), a3, voffA);
            PG8_BAR; PG8_WAIT_L(0); PG8_MMA(1, 0, At, B0); PG8_BAR; PG8_SCHED;
            PG8_STAGE(PG8_SB(1, 1), b3 + hstep, voffB);
            PG8_WAIT_V(6); PG8_BAR; PG8_MMA(1, 1, At, B1); PG8_BAR;
            }
        }
        if constexpr (ALIGN_EPI) { if (wr == 0) PG8_BAR; }
        if constexpr (Epi::MICRO) E.micro_epilogue(acc_s, cur, wr, wc, fr, fq);
        if constexpr (!Epi::AFTER_DRAIN) { E(acc, cur, wr, wc, fr, fq); S.done(cur); }
        if (!has_next) break;
        if constexpr (Epi::PREFETCH) E.prefetch(nxt);
        if constexpr (Epi::INIT) E.init(acc, nxt, wr, wc, fr, fq);
        else {
#pragma unroll
        for (int a = 0; a < 2; ++a)
#pragma unroll
            for (int b = 0; b < 2; ++b)
#pragma unroll
                for (int m = 0; m < 4; ++m)
#pragma unroll
                    for (int n = 0; n < 2; ++n) acc[a][b][m][n] = (f32x4){0.f, 0.f, 0.f, 0.f};
        }
        cur = nxt; cA = nA; cB = nB; ++ui;
        if constexpr (ALIGN_EPI) { if (wr == 1) PG8_BAR; }
    }
    PG8_WAIT_V(0);
    if constexpr (!ALIGN_EPI) { if (wr == 0) PG8_BAR; }
    PG8_BAR;
    if constexpr (Epi::AFTER_DRAIN) { E.fused(acc, cur, wr, wc, fr, fq, lds, wid, lane); S.done(cur); }
#undef PG8_MICRO_SETUP
#undef PG8_MICRO_STAGE
#undef PG8_MICRO_MMA1
#undef PG8_MMA_SP2_MICRO
#undef PG8_MICRO_MMA
#undef PG8_WAIT_VM
#undef PG8_SA
#undef PG8_SB
#undef PG8_STAGE
#undef PG8_LDA
#undef PG8_LDB
#undef PG8_MMA
#undef PG8_WAIT_V
#undef PG8_WAIT_L
#undef PG8_BAR
#undef PG8_SCHED
}
}

constexpr int NTHREADS = 512, NWAVES = 8;
constexpr int D = 1024, MP = 16384, MS = 1024, M = MP + MS, SEQ = 2048, NB = 8, NS = 128, TS = 8;
constexpr int NAB = 2568, NABP = 2816, DFF = 2816, NUP = 5632, NCC = 3072, NH = 4;
constexpr float EPS = 1e-6f;
constexpr size_t O_Y = 0, O_POOL_P = 17825792, O_POOL_S = 17948672, O_DNC_P = 19914752, O_DNC_S = 19988480, O_DN_P = 21168128, O_DN_S = 22216704,
                 O_SC_P = 38993920, O_SC_S = 39026688, O_FC_P = 39550976, O_FC_S = 39731200;
constexpr size_t MiB = 1u << 20;
constexpr size_t CTL_ZERO_BYTES = 1 * MiB;
constexpr size_t WS_WINAB = 1 * MiB;
constexpr size_t WS_WOUTAB = WS_WINAB + (size_t)2 * NABP * D * 2;
constexpr size_t WS_WINC = WS_WOUTAB + (size_t)2 * D * D * 2;
constexpr size_t WS_WOUTC = WS_WINC + (size_t)2 * NCC * D * 2;
constexpr size_t WS_WUP = WS_WOUTC + (size_t)2 * D * D * 2;
constexpr size_t WS_WDOWN = WS_WUP + (size_t)4 * NUP * D * 2;
constexpr size_t WS_POOLW = WS_WDOWN + (size_t)4 * D * DFF * 2;
constexpr size_t WS_H = WS_POOLW + (size_t)2 * 4 * 128 * 128 * 2;
constexpr size_t WS_XB = WS_H + (size_t)M * D * 2;
constexpr size_t WS_SSQ = WS_XB + (size_t)M * D * 2;
constexpr size_t WS_FIX = WS_SSQ + (size_t)M * 32 * 4;
constexpr size_t WS_HALO = WS_FIX + (size_t)68 * 2 * 2 * DFF * 4;
constexpr size_t WS_RAW = WS_HALO + (size_t)68 * 2 * DFF * 4;
constexpr size_t WS_REC = WS_RAW + (size_t)M * NABP * 2;
constexpr size_t WS_ACT = WS_RAW;
constexpr size_t WS_END = WS_REC + (size_t)1024 * 73984;
static_assert(WS_END >= WS_RAW + (size_t)M * NCC * 2, "pool holds the C-layer projection");
constexpr int REC_NEGW = 0, REC_QG = 16384, REC_AQK = 32768, REC_KDT = 40960, REC_U = 57344, REC_GE = 73728, RECSZ = 73984, REC_STAGE = 57344;
constexpr int CW_BAR = 4096;
constexpr int LDS_BYTES = 163840, LDSCTL_OFF = 163328;

typedef unsigned short bf16;
typedef unsigned v4u __attribute__((ext_vector_type(4)));
typedef unsigned v2u __attribute__((ext_vector_type(2)));
typedef float f32x4 __attribute__((ext_vector_type(4)));
typedef short bf16x8 __attribute__((ext_vector_type(8)));
#define LDS_WAIT() asm volatile("s_waitcnt lgkmcnt(0)" ::: "memory")
DI unsigned pk2(float lo, float hi) { return pg8::cvt_pk_bf16(lo, hi); }
DI unsigned short f2bf(float x) { return __builtin_bit_cast(unsigned short, (__bf16)x); }
DI float bf2f(unsigned short b) { return __uint_as_float((unsigned)b << 16); }
DI float bflo(unsigned w) { return __uint_as_float(w << 16); }
DI float bfhi(unsigned w) { return __uint_as_float(w & 0xffff0000u); }
DI float siluf(float a) { return a * __builtin_amdgcn_rcpf(1.f + __expf(-a)); }
DI float sigmoidf_(float a) { return __builtin_amdgcn_rcpf(1.f + __expf(-a)); }
DI float softplusf_(float a) { return a > 15.f ? a : 0.6931471805599453f * __builtin_amdgcn_logf(1.f + __expf(a)); }
DI int fresh_tid() { int t = threadIdx.x; asm volatile("" : "+v"(t)); return t; }
DI float wave_sum(float v) {
#pragma unroll
    for (int o = 1; o < 64; o <<= 1) v += __shfl_xor(v, o);
    return v;
}
DI float transpose_reduce64_sq(const float (&q)[64], int lane) {
    float v[32];
    { const bool up = (lane & 32) != 0;
#pragma unroll
      for (int r = 0; r < 32; ++r) { const float a = q[r] * q[r], b = q[r + 32] * q[r + 32]; const float send = up ? a : b, keep = up ? b : a; v[r] = keep + __shfl_xor(send, 32); } }
#pragma unroll
    for (int m = 16; m >= 1; m >>= 1) {
        const bool up = (lane & m) != 0;
#pragma unroll
        for (int r = 0; r < m; ++r) {
            const float send = up ? v[r] : v[r + m];
            const float keep = up ? v[r + m] : v[r];
            v[r] = keep + __shfl_xor(send, m);
        }
    }
    return v[0];
}
DI bf16x8 pack8(const f32x4& a, const f32x4& b) { v4u w; w.x = pk2(a[0], a[1]); w.y = pk2(a[2], a[3]); w.z = pk2(b[0], b[1]); w.w = pk2(b[2], b[3]); return __builtin_bit_cast(bf16x8, w); }
#define MFMA16(a, b, c) __builtin_amdgcn_mfma_f32_16x16x32_bf16((a), (b), (c), 0, 0, 0)

struct Args { const float* in[24]; float* out; unsigned char* ws; int ph_lo, ph_hi; };
#define AS4 __attribute__((address_space(4)))
struct Frame {
    LAS unsigned char* lds;
    int tid, lane, wave, G, bid, z;
    unsigned char* ws; float* out;
    DI const float* in(int k) const { const char AS4* ka = (const char AS4*)__builtin_amdgcn_kernarg_segment_ptr(); return *(const float* const AS4*)(ka + 8 * k + z); }
    DI float* pX() const { return out + O_Y; }
    DI bf16* pWinab() const { return (bf16*)(ws + WS_WINAB); }
    DI bf16* pWoutab() const { return (bf16*)(ws + WS_WOUTAB); }
    DI bf16* pWinc() const { return (bf16*)(ws + WS_WINC); }
    DI bf16* pWoutc() const { return (bf16*)(ws + WS_WOUTC); }
    DI bf16* pWup() const { return (bf16*)(ws + WS_WUP); }
    DI bf16* pWdown() const { return (bf16*)(ws + WS_WDOWN); }
    DI bf16* pPoolW() const { return (bf16*)(ws + WS_POOLW); }
    DI bf16* pH() const { return (bf16*)(ws + WS_H); }
    DI bf16* pRAW() const { return (bf16*)(ws + WS_RAW); }
    DI bf16* pACT() const { return (bf16*)(ws + WS_ACT); }
    DI unsigned char* pREC() const { return ws + WS_REC; }
    DI bf16* pXB() const { return (bf16*)(ws + WS_XB); }
    DI bf16* pSSQ() const { return (bf16*)(ws + WS_SSQ); }
    DI float* pFIX() const { return (float*)(ws + WS_FIX); }
    DI float* pHALO() const { return (float*)(ws + WS_HALO); }
};

template <class RowMap>
DI void transpose_item(const float* W, int K, int N, bf16* WT, LAS float* scr, int item, int lane, RowMap rm, const float* kscale) {
    const int nblk = (N + 31) / 32, kb = item / nblk, nb = item % nblk, k0 = 64 * kb, n0 = 32 * nb;
    float ld_[32];
#pragma unroll
    for (int i = 0; i < 32; ++i) { const int kk = 2 * i + (lane >> 5); const int n = n0 + (lane & 31); ld_[i] = n < N ? W[(size_t)(k0 + kk) * N + n] : 0.f; }
#pragma unroll
    for (int i = 0; i < 32; ++i) { const int kk = 2 * i + (lane >> 5); const float sc = kscale ? kscale[k0 + kk] : 1.f; scr[kk * 33 + (lane & 31)] = ld_[i] * sc; }
    LDS_WAIT(); asm volatile("" ::: "memory");
    const int c = lane & 7;
#pragma unroll
    for (int j = 0; j < 4; ++j) { const int n = (lane >> 3) + 8 * j; const LAS float* s = scr + (8 * c) * 33 + n;
        v4u o; o.x = pk2(s[0 * 33], s[1 * 33]); o.y = pk2(s[2 * 33], s[3 * 33]); o.z = pk2(s[4 * 33], s[5 * 33]); o.w = pk2(s[6 * 33], s[7 * 33]);
        if (n0 + n < N) *(v4u*)(WT + (size_t)rm(n0 + n) * K + k0 + 8 * c) = o; }
    LDS_WAIT(); asm volatile("" ::: "memory");
}
struct RmId { DI int operator()(int n) const { return n; } };
struct RmInC {
    DI int operator()(int n) const { if (n < D) return n; const int isx = n >= 2 * D ? 1 : 0; const int c = n - D - isx * D; return D + (c >> 7) * 256 + isx * 128 + (c & 127); } };
struct RmUp {
    DI int operator()(int n) const { const int isv = n >= DFF ? 1 : 0; const int L = n - isv * DFF; return (L >> 7) * 256 + isv * 128 + (L & 127); } };

DI void convert_weights(const Args& A, Frame& F, int gw, int NGW, int part) {
    LAS float* scr = (LAS float*)(F.lds + F.wave * 16384);
    constexpr int I_INAB = (D / 64) * ((NAB + 31) / 32), I_SQ = (D / 64) * (D / 32), I_INC = (D / 64) * (NCC / 32), I_UP = (D / 64) * (NUP / 32), I_DOWN = (DFF / 64) * (D / 32), I_POOL = 2 * 4;
    const int total = part == 0 ? I_INAB + 8 * I_POOL : (part == 1 ? I_INAB + 2 * I_SQ + I_INC + 2 * I_UP + 2 * I_DOWN : 2 * I_SQ + I_INC + 2 * I_UP + 2 * I_DOWN);
    const int lb = part == 2 ? 1 : 0;
    for (int jt = gw; jt < total; jt += NGW) {
        int j = jt;
        if (part == 0) {
            if (j < I_INAB) { transpose_item(F.in(10), D, NAB, F.pWinab(), scr, j, F.lane, RmId(), F.in(7)); continue; }
            j -= I_INAB; { const int mtx = j / I_POOL, r = j % I_POOL; transpose_item(F.in(11) + (size_t)mtx * 128 * 128, 128, 128, F.pPoolW() + (size_t)mtx * 128 * 128, scr, r, F.lane, RmId(), nullptr); continue; }
        }
        if (part == 1) { if (j < I_INAB) { transpose_item(F.in(10) + (size_t)D * NAB, D, NAB, F.pWinab() + (size_t)NABP * D, scr, j, F.lane, RmId(), F.in(7) + (size_t)2 * D); continue; } j -= I_INAB; }
        if (j < I_SQ) { transpose_item(F.in(17) + (size_t)lb * D * D, D, D, F.pWoutab() + (size_t)lb * D * D, scr, j, F.lane, RmId(), nullptr); continue; } j -= I_SQ;
        if (j < I_INC) { transpose_item(F.in(18) + (size_t)lb * D * NCC, D, NCC, F.pWinc() + (size_t)lb * NCC * D, scr, j, F.lane, RmInC(), F.in(7) + (size_t)(2 * lb + 1) * D); continue; } j -= I_INC;
        if (j < I_SQ) { transpose_item(F.in(20) + (size_t)lb * D * D, D, D, F.pWoutc() + (size_t)lb * D * D, scr, j, F.lane, RmId(), nullptr); continue; } j -= I_SQ;
        if (j < 2 * I_UP) { const int l = 2 * lb + j / I_UP, r = j % I_UP; transpose_item(F.in(21) + (size_t)l * D * NUP, D, NUP, F.pWup() + (size_t)l * NUP * D, scr, r, F.lane, RmUp(), F.in(8) + (size_t)l * D); continue; } j -= 2 * I_UP;
        { const int l = 2 * lb + j / I_DOWN, r = j % I_DOWN; transpose_item(F.in(23) + (size_t)l * DFF * D, DFF, D, F.pWdown() + (size_t)l * D * DFF, scr, r, F.lane, RmId(), nullptr); }
    }
}
DI void p0_prologue(const Args& A, Frame& F) {
    convert_weights(A, F, F.bid * NWAVES + F.wave, F.G * NWAVES, 0);
    { const int gt = F.bid * NTHREADS + F.tid, NGT = F.G * NTHREADS; constexpr int PIECES = 2 * (NABP - NAB) * (D / 8);
      for (int p = gt; p < PIECES; p += NGT) { const int l = p / ((NABP - NAB) * (D / 8)), r = p % ((NABP - NAB) * (D / 8));
          const unsigned z_ = (unsigned)F.z;
          *(v4u*)(F.pWinab() + ((size_t)l * NABP + NAB) * D + (size_t)r * 8) = (v4u){z_, z_, z_, z_}; } }
}

DI void x0_phase(const Args& A, Frame& F) {
    const int gw = F.bid * NWAVES + F.wave, NGW = F.G * NWAVES;
    for (int m = gw; m < M; m += NGW) {
        const float* src = m < MP ? F.in(0) + (size_t)m * D : F.in(1) + (size_t)(m - MP) * D;
        const f32x4* xr = (const f32x4*)src + F.lane;
        f32x4 v[4]; float s = 0.f;
#pragma unroll
        for (int j = 0; j < 4; ++j) { v[j] = xr[64 * j]; s += (v[j].x * v[j].x + v[j].y * v[j].y) + (v[j].z * v[j].z + v[j].w * v[j].w); }
        s = wave_sum(s);
        v2u* o8 = (v2u*)(F.pXB() + (size_t)m * D) + F.lane;
#pragma unroll
        for (int j = 0; j < 4; ++j) { v2u o; o.x = pk2(v[j].x, v[j].y); o.y = pk2(v[j].z, v[j].w); o8[64 * j] = o; }
        if (F.lane < 32) F.pSSQ()[(size_t)m * 32 + F.lane] = F.lane == 0 ? f2bf(s) : (bf16)0;
    }
}
DI void final_norm_phase(const Args& A, Frame& F, const float* w) {
    const int gw = F.bid * NWAVES + F.wave, NGW = F.G * NWAVES;
    f32x4 wv[4];
#pragma unroll
    for (int j = 0; j < 4; ++j) wv[j] = *((const f32x4*)w + F.lane + 64 * j);
    for (int m = gw; m < M; m += NGW) {
        const v2u* xb = (const v2u*)(F.pXB() + (size_t)m * D) + F.lane;
        f32x4 v[4]; float s = 0.f;
#pragma unroll
        for (int j = 0; j < 4; ++j) { const v2u q = xb[64 * j]; v[j] = (f32x4){bflo(q.x), bfhi(q.x), bflo(q.y), bfhi(q.y)}; s += (v[j].x * v[j].x + v[j].y * v[j].y) + (v[j].z * v[j].z + v[j].w * v[j].w); }
        const float rstd = rsqrtf(wave_sum(s) * (1.f / D) + EPS);
        f32x4* xr = (f32x4*)(F.pX() + (size_t)m * D) + F.lane;
#pragma unroll
        for (int j = 0; j < 4; ++j) xr[64 * j] = v[j] * rstd * wv[j];
    }
}

DI void ld8(const bf16* p, float (&o)[8]) { const v4u w = *(const v4u*)p; o[0] = bflo(w.x); o[1] = bfhi(w.x); o[2] = bflo(w.y); o[3] = bfhi(w.y); o[4] = bflo(w.z); o[5] = bfhi(w.z); o[6] = bflo(w.w); o[7] = bfhi(w.w); }
DI void ld8f(const float* p, float (&o)[8]) { const f32x4 a = *(const f32x4*)p, b = *((const f32x4*)p + 1); o[0] = a.x; o[1] = a.y; o[2] = a.z; o[3] = a.w; o[4] = b.x; o[5] = b.y; o[6] = b.z; o[7] = b.w; }
DI void st8f(float* p, const float (&o)[8]) { *(f32x4*)p = (f32x4){o[0], o[1], o[2], o[3]}; *((f32x4*)p + 1) = (f32x4){o[4], o[5], o[6], o[7]}; }
DI v4u pk8(const float (&o)[8]) { v4u w; w.x = pk2(o[0], o[1]); w.y = pk2(o[2], o[3]); w.z = pk2(o[4], o[5]); w.w = pk2(o[6], o[7]); return w; }

DI void ffn_fix_panel(const Args& A, Frame& F, int l, int pm) {
    constexpr int OCT = DFF / 8;
    const float* cw = F.in(22) + (size_t)l * 3 * DFF;
    const int tid = fresh_tid();
    if (tid < OCT) {
        const int L = tid * 8;
        float w0[8], w1[8], w2[8]; ld8f(cw + L, w0); ld8f(cw + DFF + L, w1); ld8f(cw + 2 * DFF + L, w2);
        float h0[8], h1[8], g0[8], g1[8], v0[8], v1[8];
        ld8f(F.pHALO() + ((size_t)(pm - 1) * 2 + 0) * DFF + L, h0); ld8f(F.pHALO() + ((size_t)(pm - 1) * 2 + 1) * DFF + L, h1);
        ld8f(F.pFIX() + ((size_t)(pm * 2 + 0) * 2) * DFF + L, g0); ld8f(F.pFIX() + ((size_t)(pm * 2 + 0) * 2 + 1) * DFF + L, v0);
        ld8f(F.pFIX() + ((size_t)(pm * 2 + 1) * 2) * DFF + L, g1); ld8f(F.pFIX() + ((size_t)(pm * 2 + 1) * 2 + 1) * DFF + L, v1);
        float o0[8], o1[8];
#pragma unroll
        for (int e = 0; e < 8; ++e) { const float a0 = w0[e] * h0[e] + w1[e] * h1[e] + w2[e] * g0[e], a1 = w0[e] * h1[e] + w1[e] * g0[e] + w2[e] * g1[e]; o0[e] = siluf(a0) * v0[e]; o1[e] = siluf(a1) * v1[e]; }
        *(v4u*)(F.pACT() + (size_t)(pm * 256) * DFF + L) = pk8(o0);
        *(v4u*)(F.pACT() + (size_t)(pm * 256 + 1) * DFF + L) = pk8(o1);
    }
}
DI void sconv_local_prompt(const Args& A, Frame& F, int i, int pm, int t) {
    const int tid = fresh_tid(); const int c = 256 * t + 8 * (tid & 31);
    const float* cw = F.in(19) + (size_t)i * 3 * D;
    float w0[8], w1[8], w2[8]; ld8f(cw + c, w0); ld8f(cw + D + c, w1); ld8f(cw + 2 * D + c, w2);
    const bool start = (pm & 7) == 0;
#pragma unroll 1
    for (int k0 = 0; k0 < 16; k0 += 4) {
        v4u qb[4], q0[4], q1[4], q2[4];
#pragma unroll
        for (int u = 0; u < 4; ++u) { const int r = (tid >> 5) + 16 * (k0 + u); const bf16* p = F.pRAW() + (size_t)(pm * 256 + r) * 2048 + c;
            qb[u] = *(const v4u*)p; q0[u] = *(const v4u*)(p + D);
            q1[u] = r >= 1 ? *(const v4u*)(p + D - 2048) : (v4u){0u, 0u, 0u, 0u};
            q2[u] = r >= 2 ? *(const v4u*)(p + D - 4096) : (v4u){0u, 0u, 0u, 0u}; }
#pragma unroll
        for (int u = 0; u < 4; ++u) { const int r = (tid >> 5) + 16 * (k0 + u), m = pm * 256 + r, pos = m & (SEQ - 1);
            const unsigned wb[4] = {qb[u].x, qb[u].y, qb[u].z, qb[u].w}, wg0[4] = {q0[u].x, q0[u].y, q0[u].z, q0[u].w}, wg1[4] = {q1[u].x, q1[u].y, q1[u].z, q1[u].w}, wg2[4] = {q2[u].x, q2[u].y, q2[u].z, q2[u].w};
            float o[8], g0[8];
#pragma unroll
            for (int e = 0; e < 4; ++e) { g0[2 * e] = bflo(wg0[e]); g0[2 * e + 1] = bfhi(wg0[e]);
                o[2 * e] = bflo(wb[e]) * (w0[2 * e] * bflo(wg2[e]) + w1[2 * e] * bflo(wg1[e]) + w2[2 * e] * g0[2 * e]);
                o[2 * e + 1] = bfhi(wb[e]) * (w0[2 * e + 1] * bfhi(wg2[e]) + w1[2 * e + 1] * bfhi(wg1[e]) + w2[2 * e + 1] * g0[2 * e + 1]); }
            if (pos >= SEQ - 2) st8f(F.out + O_SC_P + ((size_t)(i * NB + (m >> 11)) * 2 + (pos - (SEQ - 2))) * D + c, g0);
            if (r >= 2 || start) *(v4u*)(F.pH() + (size_t)m * D + c) = pk8(o); }
    }
}
DI void sconv_fix_panel(const Args& A, Frame& F, int i, int pm) {
    const int tid = fresh_tid();
    if (tid < 256) { const int c = 8 * (tid & 127), m = pm * 256 + (tid >> 7);
        const float* cw = F.in(19) + (size_t)i * 3 * D;
        float w0[8], w1[8], w2[8]; ld8f(cw + c, w0); ld8f(cw + D + c, w1); ld8f(cw + 2 * D + c, w2);
        float bb[8], g0[8], g1[8], g2[8]; ld8(F.pRAW() + (size_t)m * 2048 + c, bb); ld8(F.pRAW() + (size_t)m * 2048 + D + c, g0);
        ld8(F.pRAW() + (size_t)(m - 1) * 2048 + D + c, g1); ld8(F.pRAW() + (size_t)(m - 2) * 2048 + D + c, g2);
        float o[8];
#pragma unroll
        for (int e = 0; e < 8; ++e) o[e] = bb[e] * (w0[e] * g2[e] + w1[e] * g1[e] + w2[e] * g0[e]);
        *(v4u*)(F.pH() + (size_t)m * D + c) = pk8(o); }
}
DI void sconv_local_sample(const Args& A, Frame& F, int i, int rb, int cq) {
    const int tid = fresh_tid(); const int c = 64 * cq + 8 * (tid & 7), r = tid >> 3, m = MP + 64 * rb + r, s = (64 * rb + r) >> 3, tau = r & 7;
    const float* cw = F.in(19) + (size_t)i * 3 * D;
    const float* sp = F.in(5) + (size_t)i * NS * 2 * D + (size_t)s * 2 * D + c;
    float w0[8], w1[8], w2[8]; ld8f(cw + c, w0); ld8f(cw + D + c, w1); ld8f(cw + 2 * D + c, w2);
    float bb[8], g0[8], p1[8], p2[8]; ld8(F.pRAW() + (size_t)m * 2048 + c, bb); ld8(F.pRAW() + (size_t)m * 2048 + D + c, g0);
    if (tau >= 1) ld8(F.pRAW() + (size_t)(m - 1) * 2048 + D + c, p1); else ld8f(sp + D, p1);
    if (tau >= 2) ld8(F.pRAW() + (size_t)(m - 2) * 2048 + D + c, p2); else ld8f(sp + (tau == 0 ? 0 : D), p2);
    if (tau >= 6) st8f(F.out + O_SC_S + ((size_t)(i * NS + s) * 2 + (tau - 6)) * D + c, g0);
    float o[8];
#pragma unroll
    for (int e = 0; e < 8; ++e) o[e] = bb[e] * (w0[e] * p2[e] + w1[e] * p1[e] + w2[e] * g0[e]);
    *(v4u*)(F.pH() + (size_t)m * D + c) = pk8(o);
}
DI void pool_unit(const Args& A, Frame& F, int li, int rb, int g) {
    const int tid_ = fresh_tid(); const int lane_ = tid_ & 63, wave_ = __builtin_amdgcn_readfirstlane(tid_ >> 6);
    const int w = 2 << g;
    LAS unsigned short* Y = (LAS unsigned short*)F.lds;
    const int cq = tid_ & 31, rg = tid_ >> 5;
    const int c0 = 128 * g + 4 * cq, r0 = 4 * rg, m0 = 64 * rb + r0;
    const bool prompt = rb < 256;
    const int pbase = prompt ? ((rb & 31) * 64 + r0) : 0;
    const int s = prompt ? 0 : (m0 - MP) >> 3, tau0 = prompt ? 0 : (m0 - MP) & 7;
    const float* stp = F.in(2) + ((size_t)(li * NS + s) * 15) * 512;
    const int fr = lane_ & 15, fq = lane_ >> 4, wv = wave_;
    const bf16* wt = F.pPoolW() + ((size_t)(li * 4 + g) * 128 + 16 * wv + fr) * 128 + 8 * fq;
    bf16x8 Bw[4];
#pragma unroll
    for (int ks = 0; ks < 4; ++ks) Bw[ks] = *(const bf16x8*)(wt + 32 * ks);
    const f32x4 ps = *(const f32x4*)(F.in(12) + (size_t)li * 512 + 128 * g + 16 * wv + 4 * fq);
    float vals[19][4];
#pragma unroll
    for (int e = 0; e < 19; ++e) {
        const int off = e - 15;
        float x0 = 0.f, x1 = 0.f, x2 = 0.f, x3 = 0.f;
        if (off >= 1 - w) {
            if (prompt) { if (pbase + off >= 0) { const v2u q = *(const v2u*)(F.pRAW() + (size_t)(m0 + off) * NABP + c0); x0 = bflo(q.x); x1 = bfhi(q.x); x2 = bflo(q.y); x3 = bfhi(q.y); } }
            else { const int tp = tau0 + off;
                if (tp >= 0) { const v2u q = *(const v2u*)(F.pRAW() + (size_t)(m0 + off) * NABP + c0); x0 = bflo(q.x); x1 = bfhi(q.x); x2 = bflo(q.y); x3 = bfhi(q.y); }
                else { const f32x4 q = *(const f32x4*)(stp + (size_t)(15 + tp) * 512 + c0); x0 = q.x; x1 = q.y; x2 = q.z; x3 = q.w; } }
        }
        vals[e][0] = x0; vals[e][1] = x1; vals[e][2] = x2; vals[e][3] = x3;
    }
    float S[4] = {0.f, 0.f, 0.f, 0.f};
#pragma unroll
    for (int d = 0; d < 16; ++d) if (d < w) {
#pragma unroll
        for (int k = 0; k < 4; ++k) S[k] += vals[15 - d][k]; }
#pragma unroll
    for (int rr = 0; rr < 4; ++rr) {
        if (rr > 0) {
#pragma unroll
            for (int k = 0; k < 4; ++k) { float old = 0.f;
#pragma unroll
                for (int e = 0; e < 19; ++e) if (e == 15 + rr - w) old = vals[e][k];
                S[k] += vals[15 + rr][k] - old; } }
        const int cnt = prompt ? ((pbase + rr + 1) < w ? (pbase + rr + 1) : w) : w;
        const float inv = 1.f / (float)cnt;
        v2u o; o.x = pk2(S[0] * inv - vals[15 + rr][0], S[1] * inv - vals[15 + rr][1]); o.y = pk2(S[2] * inv - vals[15 + rr][2], S[3] * inv - vals[15 + rr][3]);
        *(LAS v2u*)(Y + (r0 + rr) * 136 + 4 * cq) = o;
    }
    if (prompt) { if ((rb & 31) == 31 && r0 >= 48) {
#pragma unroll
            for (int rr = 0; rr < 4; ++rr) { const int r = r0 + rr; if (r >= 49)
                *(f32x4*)(F.out + O_POOL_P + ((size_t)((li * NB + (rb >> 5)) * 15 + (r - 49))) * 512 + c0) = (f32x4){vals[15 + rr][0], vals[15 + rr][1], vals[15 + rr][2], vals[15 + rr][3]}; } }
    } else {
        float* op = F.out + O_POOL_S + ((size_t)(li * NS + s) * 15) * 512 + c0;
        if (tau0 == 0) {
#pragma unroll
            for (int j = 0; j < 7; ++j) *(f32x4*)(op + (size_t)j * 512) = *(const f32x4*)(stp + (size_t)(8 + j) * 512 + c0);
        }
#pragma unroll
        for (int rr = 0; rr < 4; ++rr) *(f32x4*)(op + (size_t)(7 + tau0 + rr) * 512) = (f32x4){vals[15 + rr][0], vals[15 + rr][1], vals[15 + rr][2], vals[15 + rr][3]};
    }
    __syncthreads();
#pragma unroll
    for (int mi = 0; mi < 4; ++mi) {
        f32x4 acc = {0.f, 0.f, 0.f, 0.f};
#pragma unroll
        for (int ks = 0; ks < 4; ++ks) { const bf16x8 ya = *(const LAS bf16x8*)(Y + (16 * mi + fr) * 136 + 32 * ks + 8 * fq); acc = MFMA16(Bw[ks], ya, acc); }
        v2u o; o.x = pk2(acc[0] * ps[0], acc[1] * ps[1]); o.y = pk2(acc[2] * ps[2], acc[3] * ps[3]);
        *(v2u*)(F.pH() + (size_t)(64 * rb + 16 * mi + fr) * D + 128 * g + 16 * wv + 4 * fq) = o;
    }
    __syncthreads();
}
typedef float f32x2 __attribute__((ext_vector_type(2)));
template <int I, int K>
DI void subst_ld(f32x4 (&dst)[4], const LAS float* Lm) {
#pragma unroll
    for (int v = 0; v < 4; ++v) if (16 * K + 4 * v < I) dst[v] = *(const LAS f32x4*)(Lm + I * 68 + 16 * K + 4 * v);
}
template <int I, int K, int Q>
DI void subst_step(f32x2 (&cx)[32], f32x2 (&cy)[32], f32x4 (&R)[3][4], const LAS float* Lm, f32x2& ax, f32x2& ay) {
    constexpr int N = (I + 15) >> 4;
    constexpr int i1 = (K + 1 < N) ? I : I + 1, k1 = (K + 1 < N) ? K + 1 : 0;
    constexpr int n1 = (i1 + 15) >> 4;
    constexpr int i2 = (k1 + 1 < n1) ? i1 : i1 + 1, k2 = (k1 + 1 < n1) ? k1 + 1 : 0;
    if constexpr (i2 < 64) subst_ld<i2, k2>(R[(Q + 2) % 3], Lm);
    __builtin_amdgcn_sched_barrier(0);
    if constexpr (K == 0) { ax = (f32x2){cx[I >> 1][I & 1], 0.f}; ay = (f32x2){cy[I >> 1][I & 1], 0.f}; }
#pragma unroll
    for (int v = 0; v < 4; ++v)
#pragma unroll
        for (int p = 0; p < 2; ++p) { const int j0 = 16 * K + 4 * v + 2 * p;
            if (j0 + 1 < I) { const f32x2 ll = {R[Q % 3][v][2 * p], R[Q % 3][v][2 * p + 1]}; ax -= ll * cx[j0 >> 1]; ay -= ll * cy[j0 >> 1]; }
            else if (j0 < I) { const float l = R[Q % 3][v][2 * p]; ax[0] -= l * cx[j0 >> 1][0]; ay[0] -= l * cy[j0 >> 1][0]; } }
    if constexpr (K + 1 == N) { cx[I >> 1][I & 1] = ax[0] + ax[1]; cy[I >> 1][I & 1] = ay[0] + ay[1]; }
    __builtin_amdgcn_sched_barrier(0);
    if constexpr (i1 < 64) subst_step<i1, k1, Q + 1>(cx, cy, R, Lm, ax, ay);
}
constexpr int DP_R0 = 0, DP_R1 = 17408, DP_R2 = 35840, DP_R3 = 53248, DP_GS = 70656, DP_HALF = 73728;
DI void dnprep_round(const Args& A, Frame& F, int li, int unit, bool active) {
    const int tid_ = fresh_tid(); const int half = tid_ >> 8, ht = tid_ & 255, hw = __builtin_amdgcn_readfirstlane(ht >> 6), lane = tid_ & 63;
    LAS unsigned char* LB = F.lds + half * DP_HALF;
    LAS float* GS = (LAS float*)(LB + DP_GS);
    const int n = unit & 31, h = (unit >> 5) & 3, b = unit >> 7;
    const int tb = b * SEQ + n * 64;
    unsigned char* rec = F.pREC() + (size_t)unit * RECSZ;
    if (active) {
        if (ht < 192) {
            const int cq = ht % 96, seg = ht / 96, part = cq >> 5, c4 = (cq & 31) * 4;
            const int ch = part * 512 + 128 * h + c4;
            const float* cw = F.in(13) + (size_t)li * 4 * 1536 + ch;
            const f32x4 w0 = *(const f32x4*)cw, w1 = *(const f32x4*)(cw + 1536), w2 = *(const f32x4*)(cw + 2 * 1536), w3 = *(const f32x4*)(cw + 3 * 1536);
            const bf16* rp = F.pRAW() + (size_t)(tb + 32 * seg) * NABP + 512 + ch;
            f32x4 h3 = {0.f, 0.f, 0.f, 0.f}, h2 = h3, h1 = h3;
            if (!(n == 0 && seg == 0)) { const v2u a = *(const v2u*)(rp - 3 * NABP), b2 = *(const v2u*)(rp - 2 * NABP), c2 = *(const v2u*)(rp - NABP);
                h3 = (f32x4){bflo(a.x), bfhi(a.x), bflo(a.y), bfhi(a.y)}; h2 = (f32x4){bflo(b2.x), bfhi(b2.x), bflo(b2.y), bfhi(b2.y)}; h1 = (f32x4){bflo(c2.x), bfhi(c2.x), bflo(c2.y), bfhi(c2.y)}; }
            LAS unsigned char* tile = LB + (part == 0 ? DP_R0 : (part == 1 ? DP_R1 : DP_R2));
            float* dnc = F.out + O_DNC_P + ((size_t)(li * NB + b) * 3) * 1536 + ch;
            v2u rawv[32];
#pragma unroll
            for (int r = 0; r < 32; ++r) rawv[r] = *(const v2u*)(rp + (size_t)r * NABP);
#pragma unroll
            for (int r = 0; r < 32; ++r) {
                const v2u cu = rawv[r];
                const f32x4 c = {bflo(cu.x), bfhi(cu.x), bflo(cu.y), bfhi(cu.y)};
                const f32x4 a = w0 * h3 + w1 * h2 + w2 * h1 + w3 * c;
                v2u o; o.x = pk2(a[0] * __builtin_amdgcn_rcpf(1.f + __expf(-a[0])), a[1] * __builtin_amdgcn_rcpf(1.f + __expf(-a[1])));
                o.y = pk2(a[2] * __builtin_amdgcn_rcpf(1.f + __expf(-a[2])), a[3] * __builtin_amdgcn_rcpf(1.f + __expf(-a[3])));
                *(LAS v2u*)(tile + ((32 * seg + r) * 136 + c4) * 2) = o;
                if (n == 31 && seg == 1 && r >= 29) *(f32x4*)(dnc + (size_t)(r - 29) * 1536) = c;
                h3 = h2; h2 = h1; h1 = c;
            }
        } else {
            const float bl = bf2f(F.pRAW()[(size_t)(tb + lane) * NABP + 2560 + h]), al = bf2f(F.pRAW()[(size_t)(tb + lane) * NABP + 2564 + h]);
            const float beta = sigmoidf_(bl);
            const float g = -__expf(F.in(14)[li * 4 + h]) * softplusf_(al + F.in(15)[li * 4 + h]);
            float gc = g;
#pragma unroll
            for (int o = 1; o < 64; o <<= 1) { const float t = __int_as_float(__builtin_amdgcn_ds_bpermute((lane >= o ? lane - o : lane) << 2, __float_as_int(gc))); if (lane >= o) gc += t; }
            const float gcl = __int_as_float(__builtin_amdgcn_readlane(__float_as_int(gc), 63));
            GS[lane] = beta; GS[64 + lane] = gc; GS[128 + lane] = beta * __expf(gc); GS[192 + lane] = __expf(gcl - gc); if (lane == 63) GS[256] = gc;
        }
    }
    __syncthreads();
    if (active) {
        const int row = ht >> 2, wk = (ht >> 1) & 1, hf = ht & 1;
        LAS unsigned char* p = LB + (wk ? DP_R1 : DP_R0) + (row * 136 + 64 * hf) * 2;
        v4u x[8]; float ss = 0.f;
#pragma unroll
        for (int e = 0; e < 8; ++e) { x[e] = *(const LAS v4u*)(p + 16 * e);
            const float a0 = bflo(x[e].x), a1 = bfhi(x[e].x), a2 = bflo(x[e].y), a3 = bfhi(x[e].y), a4 = bflo(x[e].z), a5 = bfhi(x[e].z), a6 = bflo(x[e].w), a7 = bfhi(x[e].w);
            ss += ((a0 * a0 + a1 * a1) + (a2 * a2 + a3 * a3)) + ((a4 * a4 + a5 * a5) + (a6 * a6 + a7 * a7)); }
        ss += __shfl_xor(ss, 1);
        const float rn = rsqrtf(ss + EPS) * (wk ? 1.f : 0.08838834764831845f);
#pragma unroll
        for (int e = 0; e < 8; ++e) { v4u o; o.x = pk2(bflo(x[e].x) * rn, bfhi(x[e].x) * rn); o.y = pk2(bflo(x[e].y) * rn, bfhi(x[e].y) * rn); o.z = pk2(bflo(x[e].z) * rn, bfhi(x[e].z) * rn); o.w = pk2(bflo(x[e].w) * rn, bfhi(x[e].w) * rn);
            *(LAS v4u*)(p + 16 * e) = o; }
    }
    __syncthreads();
    if (active) {
        const int mi = hw, fr = lane & 15, fq = lane >> 4, i = 16 * mi + fr;
        const float gci = GS[64 + i], bi = GS[i];
        bf16x8 Yq[4], Yk[4];
#pragma unroll
        for (int ks = 0; ks < 4; ++ks) { Yq[ks] = *(const LAS bf16x8*)(LB + DP_R0 + (i * 136 + 32 * ks + 8 * fq) * 2); Yk[ks] = *(const LAS bf16x8*)(LB + DP_R1 + (i * 136 + 32 * ks + 8 * fq) * 2); }
        v2u aq[4];
#pragma unroll
        for (int nj = 0; nj < 4; ++nj) {
            aq[nj] = (v2u){0u, 0u};
            if (nj <= mi) {
                f32x4 accQ = {0.f, 0.f, 0.f, 0.f}, accK = {0.f, 0.f, 0.f, 0.f};
#pragma unroll
                for (int ks = 0; ks < 4; ++ks) { const bf16x8 X = *(const LAS bf16x8*)(LB + DP_R1 + ((16 * nj + fr) * 136 + 32 * ks + 8 * fq) * 2); accQ = MFMA16(X, Yq[ks], accQ); accK = MFMA16(X, Yk[ks], accK); }
                float a4[4]; f32x4 l4;
#pragma unroll
                for (int r = 0; r < 4; ++r) { const int j = 16 * nj + 4 * fq + r; const float gcj = GS[64 + j];
                    const float dec = (j <= i) ? __expf(gci - gcj) : 0.f;
                    a4[r] = accQ[r] * dec; l4[r] = (j < i) ? bi * accK[r] * dec : 0.f; }
                aq[nj] = (v2u){pk2(a4[0], a4[1]), pk2(a4[2], a4[3])};
                *(LAS f32x4*)(LB + DP_R3 + (i * 68 + 16 * nj + 4 * fq) * 4) = l4;
            }
        }
#pragma unroll
        for (int js = 0; js < 2; ++js) *(v4u*)(rec + REC_AQK + (size_t)((mi * 2 + js) * 64 + lane) * 16) = (v4u){aq[2 * js].x, aq[2 * js].y, aq[2 * js + 1].x, aq[2 * js + 1].y};
    }
    const int aw = hw - 2 * half; const bool sact = active && (aw == 0 || aw == 1); const bool kthr = aw == 0;
    f32x2 cx[32], cy[32];
    if (sact) {
        const LAS unsigned* tp = (const LAS unsigned*)(LB + (kthr ? DP_R1 : DP_R2)) + lane;
        const LAS float* cf = GS + (kthr ? 128 : 0);
#pragma unroll
        for (int i = 0; i < 64; ++i) { const unsigned q = tp[i * 68]; const float sc = cf[i]; cx[i >> 1][i & 1] = bflo(q) * sc; cy[i >> 1][i & 1] = bfhi(q) * sc; }
    }
    __syncthreads();
    if (sact) {
        const LAS float* Lm = (const LAS float*)(LB + DP_R3);
        asm volatile("" : "+v"(Lm));
        f32x4 R[3][4]; f32x2 ax, ay;
        subst_ld<1, 0>(R[0], Lm); subst_ld<2, 0>(R[1], Lm);
        __builtin_amdgcn_sched_barrier(0);
        subst_step<1, 0, 0>(cx, cy, R, Lm, ax, ay);
    } else if (active) {
        const int it = (half == 0 ? hw - 2 : hw) * 64 + lane;
#pragma unroll 1
        for (int e = 0; e < 8; ++e) { const int p = it + 128 * e; const int fr_ = p >> 6, ln = p & 63, qq = ln >> 4, cc = ln & 15;
            { const int mi = fr_ >> 2, ks = fr_ & 3, i = 16 * mi + cc, ka = 32 * ks + 4 * qq; const float gm = __expf(GS[64 + i]);
              const v2u a = *(const LAS v2u*)(LB + DP_R0 + (i * 136 + ka) * 2), bq = *(const LAS v2u*)(LB + DP_R0 + (i * 136 + ka + 16) * 2);
              *(v4u*)(rec + REC_QG + (size_t)p * 16) = (v4u){pk2(bflo(a.x) * gm, bfhi(a.x) * gm), pk2(bflo(a.y) * gm, bfhi(a.y) * gm), pk2(bflo(bq.x) * gm, bfhi(bq.x) * gm), pk2(bflo(bq.y) * gm, bfhi(bq.y) * gm)}; }
            { const int kf = fr_ >> 1, js = fr_ & 1, k = 16 * kf + cc, ia = 32 * js + 4 * qq;
              const LAS unsigned short* kp = (const LAS unsigned short*)(LB + DP_R1) + k;
              float v[8];
#pragma unroll
              for (int j = 0; j < 8; ++j) { const int i = ia + (j & 3) + 16 * (j >> 2); v[j] = bf2f(kp[i * 136]) * GS[192 + i]; }
              *(v4u*)(rec + REC_KDT + (size_t)p * 16) = (v4u){pk2(v[0], v[1]), pk2(v[2], v[3]), pk2(v[4], v[5]), pk2(v[6], v[7])}; }
        }
    }
    __syncthreads();
    if (sact) {
        if (kthr) {
#pragma unroll
            for (int i = 0; i < 64; ++i) ((LAS unsigned*)(LB + DP_R0))[i * 68 + lane] = pk2(-cx[i >> 1][i & 1], -cy[i >> 1][i & 1]);
        } else {
#pragma unroll
            for (int j = 0; j < 8; ++j) {
                *(LAS v4u*)(LB + DP_R1 + ((2 * lane) * 72 + 8 * j) * 2) = (v4u){pk2(cx[4 * j][0], cx[4 * j][1]), pk2(cx[4 * j + 1][0], cx[4 * j + 1][1]), pk2(cx[4 * j + 2][0], cx[4 * j + 2][1]), pk2(cx[4 * j + 3][0], cx[4 * j + 3][1])};
                *(LAS v4u*)(LB + DP_R1 + ((2 * lane + 1) * 72 + 8 * j) * 2) = (v4u){pk2(cy[4 * j][0], cy[4 * j][1]), pk2(cy[4 * j + 1][0], cy[4 * j + 1][1]), pk2(cy[4 * j + 2][0], cy[4 * j + 2][1]), pk2(cy[4 * j + 3][0], cy[4 * j + 3][1])};
            }
        }
    }
    __syncthreads();
    if (active) {
#pragma unroll 1
        for (int e = 0; e < 4; ++e) { const int p = ht + 256 * e; const int fr_ = p >> 6, ln = p & 63, qq = ln >> 4, cc = ln & 15;
            const int mi = fr_ >> 2, ks = fr_ & 3, i = 16 * mi + cc, ka = 32 * ks + 4 * qq;
            const v2u a = *(const LAS v2u*)(LB + DP_R0 + (i * 136 + ka) * 2), bq = *(const LAS v2u*)(LB + DP_R0 + (i * 136 + ka + 16) * 2);
            *(v4u*)(rec + REC_NEGW + (size_t)p * 16) = (v4u){a.x, a.y, bq.x, bq.y}; }
#pragma unroll 1
        for (int e = 0; e < 8; ++e) { const int p = ht + 256 * e; const int fr_ = p >> 6, ln = p & 63, qq = ln >> 4, cc = ln & 15;
            const int vs = fr_ >> 2, mi = fr_ & 3, v = 16 * vs + cc, i = 16 * mi + 4 * qq;
            *(v2u*)(rec + REC_U + (size_t)p * 8) = *(const LAS v2u*)(LB + DP_R1 + (v * 72 + i) * 2); }
        if (ht == 0) *(float*)(rec + REC_GE) = __expf(GS[256]);
    }
    __syncthreads();
}
constexpr int SC_A0 = 0, SC_A1 = 57344, SC_OB = 114688;
DI void scan_block(const Args& A, Frame& F, int li, int bh) {
    const int tid = fresh_tid(); const int lane = tid & 63, vs = __builtin_amdgcn_readfirstlane(tid >> 6);
    const int b = bh >> 2, h = bh & 3, fq = lane >> 4, fc_ = lane & 15;
    const unsigned char* rec0 = F.pREC() + (size_t)(bh * 32) * RECSZ;
    f32x4 Hf[8]; bf16x8 Hb[4];
#pragma unroll
    for (int k = 0; k < 8; ++k) Hf[k] = (f32x4){0.f, 0.f, 0.f, 0.f};
#pragma unroll
    for (int k = 0; k < 4; ++k) Hb[k] = (bf16x8){0, 0, 0, 0, 0, 0, 0, 0};
#pragma unroll
    for (int e = 0; e < 7; ++e) { const int p = tid + 512 * e; *(LAS v4u*)(F.lds + SC_A0 + p * 16) = *(const v4u*)(rec0 + (size_t)p * 16); }
    LAS float* OB = (LAS float*)(F.lds + SC_OB);
    const int gi = tid >> 3, gc_ = tid & 7;
    const bf16* zbase = F.pRAW() + (size_t)(b * SEQ + gi) * NABP + 2048 + 128 * h + 16 * gc_;
    v2u un[4]; float gen; v4u zn0, zn1;
#pragma unroll
    for (int mi = 0; mi < 4; ++mi) un[mi] = *(const v2u*)(rec0 + REC_U + (size_t)((vs * 4 + mi) * 64 + lane) * 8);
    gen = *(const float*)(rec0 + REC_GE); zn0 = *(const v4u*)zbase; zn1 = *(const v4u*)(zbase + 8);
    __syncthreads();
#pragma unroll 1
    for (int n = 0; n < 32; ++n) {
        const unsigned char* rec = rec0 + (size_t)n * RECSZ;
        LAS unsigned char* Acur = F.lds + ((n & 1) ? SC_A1 : SC_A0);
        const float ge = gen; const v4u z0 = zn0, z1 = zn1;
        f32x4 au[4];
#pragma unroll
        for (int mi = 0; mi < 4; ++mi) au[mi] = (f32x4){bflo(un[mi].x), bfhi(un[mi].x), bflo(un[mi].y), bfhi(un[mi].y)};
        v4u pre[7];
        if (n + 1 < 32) {
#pragma unroll
            for (int e = 0; e < 7; ++e) pre[e] = __builtin_nontemporal_load((const v4u*)(rec + RECSZ + (size_t)(tid + 512 * e) * 16));
#pragma unroll
            for (int mi = 0; mi < 4; ++mi) un[mi] = __builtin_nontemporal_load((const v2u*)(rec + RECSZ + REC_U + (size_t)((vs * 4 + mi) * 64 + lane) * 8));
            gen = *(const float*)(rec + RECSZ + REC_GE);
            zn0 = __builtin_nontemporal_load((const v4u*)(zbase + (size_t)(n + 1) * 64 * NABP)); zn1 = __builtin_nontemporal_load((const v4u*)(zbase + (size_t)(n + 1) * 64 * NABP + 8));
        }
#define LDB(dst, off) do { _Pragma("unroll") for (int e_ = 0; e_ < 8; ++e_) dst[e_] = *(const LAS bf16x8*)(Acur + (off) + (e_ * 64 + lane) * 16); asm volatile("" ::: "memory"); } while (0)
        bf16x8 fa[8], fb[8], fc[8];
        LDB(fa, REC_NEGW); LDB(fb, REC_NEGW + 8192); LDB(fc, REC_QG);
#pragma unroll
        for (int e = 0; e < 8; ++e) au[e >> 2] = MFMA16(fa[e], Hb[e & 3], au[e >> 2]);
        LDB(fa, REC_QG + 8192);
#pragma unroll
        for (int e = 0; e < 8; ++e) au[2 + (e >> 2)] = MFMA16(fb[e], Hb[e & 3], au[2 + (e >> 2)]);
        LDB(fb, REC_AQK);
        bf16x8 ub[2];
        ub[0] = pack8(au[0], au[1]); ub[1] = pack8(au[2], au[3]);
        f32x4 ao[4];
#pragma unroll
        for (int mi = 0; mi < 4; ++mi) ao[mi] = (f32x4){0.f, 0.f, 0.f, 0.f};
#pragma unroll
        for (int e = 0; e < 8; ++e) ao[e >> 2] = MFMA16(fc[e], Hb[e & 3], ao[e >> 2]);
        LDB(fc, REC_KDT);
#pragma unroll
        for (int e = 0; e < 8; ++e) ao[2 + (e >> 2)] = MFMA16(fa[e], Hb[e & 3], ao[2 + (e >> 2)]);
        LDB(fa, REC_KDT + 8192);
#pragma unroll
        for (int e = 0; e < 8; ++e) ao[e >> 1] = MFMA16(fb[e], ub[e & 1], ao[e >> 1]);
#pragma unroll
        for (int mi = 0; mi < 4; ++mi)
#pragma unroll
            for (int r = 0; r < 4; ++r) OB[(16 * mi + 4 * fq + r) * 132 + 16 * vs + fc_ + 0] = ao[mi][r];
#pragma unroll
        for (int kf = 0; kf < 8; ++kf) Hf[kf] = Hf[kf] * ge;
#pragma unroll
        for (int e = 0; e < 8; ++e) Hf[e >> 1] = MFMA16(fc[e], ub[e & 1], Hf[e >> 1]);
#pragma unroll
        for (int e = 0; e < 8; ++e) Hf[4 + (e >> 1)] = MFMA16(fa[e], ub[e & 1], Hf[4 + (e >> 1)]);
#undef LDB
#pragma unroll
        for (int ks = 0; ks < 4; ++ks) Hb[ks] = pack8(Hf[2 * ks], Hf[2 * ks + 1]);
        __syncthreads();
        { float o[16];
#pragma unroll
          for (int e = 0; e < 4; ++e) { const f32x4 t = *(const LAS f32x4*)(OB + gi * 132 + 16 * gc_ + 4 * e); o[4 * e] = t.x; o[4 * e + 1] = t.y; o[4 * e + 2] = t.z; o[4 * e + 3] = t.w; }
          float ss = 0.f;
#pragma unroll
          for (int e = 0; e < 16; ++e) ss += o[e] * o[e];
          ss += __shfl_xor(ss, 1); ss += __shfl_xor(ss, 2); ss += __shfl_xor(ss, 4);
          const float rstd = rsqrtf(ss * (1.f / 128.f) + EPS);
          const unsigned zw[8] = {z0.x, z0.y, z0.z, z0.w, z1.x, z1.y, z1.z, z1.w};
          unsigned ow[8];
#pragma unroll
          for (int e = 0; e < 8; ++e) ow[e] = pk2(o[2 * e] * rstd * bflo(zw[e]), o[2 * e + 1] * rstd * bfhi(zw[e]));
          bf16* dst = F.pH() + (size_t)(b * SEQ + n * 64 + gi) * D + 512 + 128 * h + 16 * gc_;
          *(v4u*)dst = (v4u){ow[0], ow[1], ow[2], ow[3]};
          *(v4u*)(dst + 8) = (v4u){ow[4], ow[5], ow[6], ow[7]};
        }
        if (n + 1 < 32) { LAS unsigned char* An = F.lds + ((n & 1) ? SC_A0 : SC_A1);
#pragma unroll
            for (int e = 0; e < 7; ++e) *(LAS v4u*)(An + (tid + 512 * e) * 16) = pre[e]; }
        __syncthreads();
    }
    float* op = F.out + O_DN_P + ((size_t)((li * NB + b) * NH + h) * 128) * 128;
#pragma unroll
    for (int kf = 0; kf < 8; ++kf)
#pragma unroll
        for (int r = 0; r < 4; ++r) op[(size_t)(16 * kf + 4 * fq + r) * 128 + 16 * vs + fc_] = Hf[kf][r];
}

constexpr int SM_QKV = 0, SM_RED = 12288, SM_OB = 20480, SM_G = 24576;
DI void sample_unit(const Args& A, Frame& F, int li, int u) {
    const int tid = fresh_tid(); const int s = u >> 2, h = u & 3, lane = tid & 63, wv = __builtin_amdgcn_readfirstlane(tid >> 6);
    LAS float* QKV = (LAS float*)(F.lds + SM_QKV); LAS float* RED = (LAS float*)(F.lds + SM_RED); LAS float* OBf = (LAS float*)(F.lds + SM_OB); LAS float* GG = (LAS float*)(F.lds + SM_G);
    const int mb = MP + 8 * s;
    const int v = tid & 127, kq = tid >> 7;
    const float* sp = F.in(4) + ((size_t)((li * NS + s) * NH + h) * 128 + 32 * kq) * 128 + v;
    float S[32];
#pragma unroll
    for (int kk = 0; kk < 32; ++kk) S[kk] = sp[(size_t)kk * 128];
    if (tid < 384) {
        const int part = tid >> 7, c = tid & 127, ch = part * 512 + 128 * h + c;
        const float* cw = F.in(13) + (size_t)li * 4 * 1536 + ch;
        const float w0 = cw[0], w1 = cw[1536], w2 = cw[2 * 1536], w3 = cw[3 * 1536];
        const float* stc = F.in(3) + ((size_t)(li * NS + s) * 3) * 1536 + ch;
        float h3 = stc[0], h2 = stc[1536], h1 = stc[2 * 1536];
#pragma unroll
        for (int t = 0; t < 8; ++t) { const float cu = bf2f(F.pRAW()[(size_t)(mb + t) * NABP + 512 + ch]); const float a = w0 * h3 + w1 * h2 + w2 * h1 + w3 * cu; QKV[(part * 8 + t) * 128 + c] = siluf(a);
            if (t >= 5) F.out[O_DNC_S + ((size_t)(li * NS + s) * 3 + (t - 5)) * 1536 + ch] = cu;
            h3 = h2; h2 = h1; h1 = cu; }
    } else if (tid < 392) {
        const int t = tid - 384;
        const float bl = bf2f(F.pRAW()[(size_t)(mb + t) * NABP + 2560 + h]), al = bf2f(F.pRAW()[(size_t)(mb + t) * NABP + 2564 + h]);
        GG[t] = sigmoidf_(bl); GG[8 + t] = __expf(-__expf(F.in(14)[li * 4 + h]) * softplusf_(al + F.in(15)[li * 4 + h]));
    }
    __syncthreads();
#pragma unroll
    for (int e = 0; e < 2; ++e) { const int r = 2 * wv + e; LAS float* row = QKV + r * 128; const float a = row[lane], bq = row[lane + 64];
        const float ss = wave_sum(a * a + bq * bq); const float rn = rsqrtf(ss + EPS) * (r < 8 ? 0.08838834764831845f : 1.f); row[lane] = a * rn; row[lane + 64] = bq * rn; }
    __syncthreads();
    { const float a = QKV[wv * 128 + lane] * QKV[(8 + wv) * 128 + lane] + QKV[wv * 128 + lane + 64] * QKV[(8 + wv) * 128 + lane + 64]; const float qk = wave_sum(a); if (lane == 0) GG[16 + wv] = qk; }
    __syncthreads();
#pragma unroll 1
    for (int t = 0; t < 8; ++t) {
        const LAS float* qv = QKV + t * 128 + 32 * kq; const LAS float* kv = QKV + (8 + t) * 128 + 32 * kq;
        float pk = 0.f, pq = 0.f; float kreg[32];
#pragma unroll
        for (int k4 = 0; k4 < 8; ++k4) { const f32x4 kk4 = *(const LAS f32x4*)(kv + 4 * k4), qq4 = *(const LAS f32x4*)(qv + 4 * k4);
#pragma unroll
            for (int e = 0; e < 4; ++e) { kreg[4 * k4 + e] = kk4[e]; pk += kk4[e] * S[4 * k4 + e]; pq += qq4[e] * S[4 * k4 + e]; } }
        LAS float* rd = RED + (t & 1) * 1024;
        rd[kq * 128 + v] = pk; rd[512 + kq * 128 + v] = pq;
        __syncthreads();
        const float kS = (rd[v] + rd[128 + v]) + (rd[256 + v] + rd[384 + v]);
        const float qS = (rd[512 + v] + rd[640 + v]) + (rd[768 + v] + rd[896 + v]);
        const float gam = GG[8 + t], beta = GG[t], qk = GG[16 + t];
        const float uu = beta * (QKV[(16 + t) * 128 + v] - gam * kS);
        if (kq == 0) OBf[t * 128 + v] = gam * qS + qk * uu;
#pragma unroll
        for (int kk = 0; kk < 32; ++kk) S[kk] = gam * S[kk] + kreg[kk] * uu;
    }
    float* so = F.out + O_DN_S + ((size_t)((li * NS + s) * NH + h) * 128 + 32 * kq) * 128 + v;
#pragma unroll
    for (int kk = 0; kk < 32; ++kk) so[(size_t)kk * 128] = S[kk];
    __syncthreads();
    { const int t = wv; const float a = OBf[t * 128 + lane], bq = OBf[t * 128 + lane + 64];
      const float rstd = rsqrtf(wave_sum(a * a + bq * bq) * (1.f / 128.f) + EPS);
      const float* nw = F.in(16) + (size_t)li * 128; const size_t m = (size_t)(mb + t);
      const float z0 = bf2f(F.pRAW()[m * NABP + 2048 + 128 * h + lane]), z1 = bf2f(F.pRAW()[m * NABP + 2048 + 128 * h + lane + 64]);
      F.pH()[m * D + 512 + 128 * h + lane] = f2bf(a * rstd * z0);
      F.pH()[m * D + 512 + 128 * h + lane + 64] = f2bf(bq * rstd * z1); }
    __syncthreads();
}
struct MicroResNorm { static DI int brow(int cb, int prow) { return 64 * cb + prow; } static DI void remap(int u, int& rb, int& cb) { rb = u & 15; cb = u >> 4; } bf16* XB; bf16* SSQ;
    DI void operator()(const f32x4& a0, const f32x4& a1, int row, int col, int fq) const {
        bf16* p = XB + (size_t)row * D + col; float s = 0.f;
#pragma unroll
        for (int nf = 0; nf < 2; ++nf) { const f32x4 a = nf ? a1 : a0; const v2u o = *(const v2u*)(p + 16 * nf);
            const float t0 = bflo(o.x) + a[0], t1 = bfhi(o.x) + a[1], t2 = bflo(o.y) + a[2], t3 = bfhi(o.y) + a[3];
            s += (t0 * t0 + t1 * t1) + (t2 * t2 + t3 * t3);
            *(v2u*)(p + 16 * nf) = (v2u){pk2(t0, t1), pk2(t2, t3)}; }
        s += __shfl_xor(s, 16); s += __shfl_xor(s, 32);
        if (fq == 0) SSQ[(size_t)row * 32 + (col >> 5)] = f2bf(s);
    } };
struct MicroBf16CX { bf16* O; const bf16* SSQ;
    static DI void remap(int u, int& rb, int& cb) { const int k = u >> 8, c = u & 255; rb = c & 15; cb = k == 0 ? (c >> 4) : 16 + 2 * (c >> 4) + (k - 1); }
    static DI int brow(int cb, int prow) { if (cb < 16) return 64 * cb + prow; const int ch = 32 * (cb - 16) + 16 * (prow >> 5) + (prow & 15); return D + (ch >> 7) * 256 + ((prow >> 4) & 1) * 128 + (ch & 127); }
    DI void operator()(const f32x4& a0, const f32x4& a1, int row, int col, int fq) const {
        const bf16* sp = SSQ + (size_t)row * 32; float s = 0.f;
#pragma unroll
        for (int e = 0; e < 4; ++e) { const v4u t = *(const v4u*)(sp + 8 * e); s += (bflo(t.x) + bfhi(t.x)) + (bflo(t.y) + bfhi(t.y)) + (bflo(t.z) + bfhi(t.z)) + (bflo(t.w) + bfhi(t.w)); }
        const float rs = rsqrtf(s * (1.f / 1024.f) + EPS);
        const int cb = col >> 6;
        if (cb < 16) { bf16* p = O + (size_t)row * 2048 + col;
            *(v2u*)p = (v2u){pk2(a0[0] * rs, a0[1] * rs), pk2(a0[2] * rs, a0[3] * rs)};
            *(v2u*)(p + 16) = (v2u){pk2(a1[0] * rs, a1[1] * rs), pk2(a1[2] * rs, a1[3] * rs)};
        } else { const float r2 = rs * rs; bf16* p = O + (size_t)row * 2048 + 1024 + 32 * (cb - 16) + 16 * ((col >> 5) & 1) + (col & 15);
            *(v2u*)p = (v2u){pk2(a0[0] * a1[0] * r2, a0[1] * a1[1] * r2), pk2(a0[2] * a1[2] * r2, a0[3] * a1[3] * r2)}; }
    } };
struct MicroBf16N { bf16* O; int ldc; const bf16* SSQ;
    static DI void remap(int u, int& rb, int& cb) { rb = u & 15; cb = u >> 4; }
    static DI int brow(int cb, int prow) { return 64 * cb + prow; }
    DI void operator()(const f32x4& a0, const f32x4& a1, int row, int col, int fq) const {
        const bf16* sp = SSQ + (size_t)row * 32; float s = 0.f;
#pragma unroll
        for (int e = 0; e < 4; ++e) { const v4u t = *(const v4u*)(sp + 8 * e); s += (bflo(t.x) + bfhi(t.x)) + (bflo(t.y) + bfhi(t.y)) + (bflo(t.z) + bfhi(t.z)) + (bflo(t.w) + bfhi(t.w)); }
        const float rs = rsqrtf(s * (1.f / 1024.f) + EPS);
        bf16* p = O + (size_t)row * ldc + col;
        *(v2u*)p = (v2u){pk2(a0[0] * rs, a0[1] * rs), pk2(a0[2] * rs, a0[3] * rs)};
        *(v2u*)(p + 16) = (v2u){pk2(a1[0] * rs, a1[1] * rs), pk2(a1[2] * rs, a1[3] * rs)};
    } };
template <class Epi>
DI void micro_phase(Frame& F, const bf16* Am, const bf16* Bt, int K, int N, const Epi& E) {
    const int tid = fresh_tid(); const int lane = tid & 63, wv = __builtin_amdgcn_readfirstlane(tid >> 6), fr = lane & 15, fq = lane >> 4;
    const int mi = wv & 3, nh = wv >> 2;
    const int nunits = 16 * (N >> 6), nchunk = K >> 6;
    LAS unsigned char* ring = F.lds;
    const int prow = tid >> 3, pseg = (tid & 7) ^ (prow & 7);
    int aoff[2], boff[2][2];
#pragma unroll
    for (int ks = 0; ks < 2; ++ks) { const int seg = 4 * ks + fq; { const int r = 16 * mi + fr; aoff[ks] = r * 128 + ((seg ^ (r & 7)) << 4); }
#pragma unroll
        for (int nf = 0; nf < 2; ++nf) { const int r = 32 * nh + 16 * nf + fr; boff[nf][ks] = 8192 + r * 128 + ((seg ^ (r & 7)) << 4); } }
#pragma unroll 1
    for (int u = F.bid; u < nunits; u += F.G) {
        int rb, cb; Epi::remap(u, rb, cb);
        const bf16* ga = Am + (size_t)(MP + 64 * rb + prow) * K + 8 * pseg;
        const bf16* gb = Bt + (size_t)Epi::brow(cb, prow) * K + 8 * pseg;
#define MICRO_ISSUE(c) do { LAS unsigned char* s_ = ring + (((c) & 7) << 14) + (wv << 10); \
        __builtin_amdgcn_global_load_lds((const unsigned*)(ga + ((c) << 6)), (LAS unsigned*)s_, 16, 0, 0); \
        __builtin_amdgcn_global_load_lds((const unsigned*)(gb + ((c) << 6)), (LAS unsigned*)(s_ + 8192), 16, 0, 0); } while (0)
        for (int c = 0; c < 6 && c < nchunk; ++c) MICRO_ISSUE(c);
        f32x4 acc0 = {0.f, 0.f, 0.f, 0.f}, acc1 = {0.f, 0.f, 0.f, 0.f};
#pragma unroll 1
        for (int c = 0; c < nchunk; ++c) {
            if (c + 6 <= nchunk) asm volatile("s_waitcnt vmcnt(10)" ::: "memory"); else asm volatile("s_waitcnt vmcnt(0)" ::: "memory");
            __builtin_amdgcn_s_barrier(); asm volatile("" ::: "memory");
            const LAS unsigned char* sl = ring + ((c & 7) << 14);
            const bf16x8 a0 = *(const LAS bf16x8*)(sl + aoff[0]), a1 = *(const LAS bf16x8*)(sl + aoff[1]);
            const bf16x8 b00 = *(const LAS bf16x8*)(sl + boff[0][0]), b01 = *(const LAS bf16x8*)(sl + boff[0][1]), b10 = *(const LAS bf16x8*)(sl + boff[1][0]), b11 = *(const LAS bf16x8*)(sl + boff[1][1]);
            acc0 = MFMA16(b00, a0, acc0); acc1 = MFMA16(b10, a0, acc1); acc0 = MFMA16(b01, a1, acc0); acc1 = MFMA16(b11, a1, acc1);
            asm volatile("s_waitcnt lgkmcnt(0)" ::: "memory");
            if (c + 6 < nchunk) MICRO_ISSUE(c + 6);
        }
#undef MICRO_ISSUE
        E(acc0, acc1, MP + 64 * rb + 16 * mi + fr, 64 * cb + 32 * nh + 4 * fq, fq);
        asm volatile("s_waitcnt vmcnt(0) lgkmcnt(0)" ::: "memory"); __builtin_amdgcn_s_barrier(); asm volatile("" ::: "memory");
    }
}

constexpr int N_PHASES = 22;
DI void decode_phase(int ph, int& l, int& sub) {
    if (ph == 0) { l = -1; sub = 0; return; }
    if (ph == N_PHASES - 1) { l = 4; sub = 0; return; }
    const int q = ph - 1;
    l = (q >= 16) ? 3 : (q >= 10) ? 2 : (q >= 6) ? 1 : 0;
    const int sq = q - ((l == 3) ? 16 : (l == 2) ? 10 : (l == 1) ? 6 : 0);
    if (l & 1) sub = sq == 0 ? 0 : (sq == 1 ? 3 : (sq == 2 ? 4 : 6));
    else sub = sq <= 4 ? sq : 6;
}
__global__ void __launch_bounds__(NTHREADS, 2) mega_fwd(Args A) {
    extern __shared__ __attribute__((aligned(16))) unsigned char lds_raw[];
    cg::grid_group grid = cg::this_grid();
    Frame F;
    F.lds = (LAS unsigned char*)lds_raw;
    F.tid = threadIdx.x; F.lane = F.tid & 63; F.wave = __builtin_amdgcn_readfirstlane(F.tid >> 6);
    F.G = gridDim.x; F.bid = blockIdx.x;
    F.z = 0; F.out = A.out; F.ws = A.ws;
    volatile LAS unsigned* MISC = (volatile LAS unsigned*)(F.lds + LDSCTL_OFF);
    for (int u = F.tid; u < (LDS_BYTES - LDSCTL_OFF) / 4; u += NTHREADS) ((LAS unsigned*)(F.lds + LDSCTL_OFF))[u] = 0u;
    __syncthreads();
    const int lo = A.ph_lo, hi = A.ph_hi < N_PHASES ? A.ph_hi : N_PHASES;
    XcdBarrier bar; bar.bar = (unsigned*)A.ws + CW_BAR; bar.x = xb_xcc_id(); bar.st = MISC + 8;
    if (blockIdx.x == 0) for (int u = F.tid; u < XCD_BAR_WORDS; u += NTHREADS) ((unsigned*)A.ws + CW_BAR)[u] = 0u;
#pragma unroll 1
    for (int ph = lo; ph < hi; ++ph) {
        { int z = 0; asm volatile("" : "+s"(z)); F.z = z;
          { int b_ = blockIdx.x, g_ = gridDim.x; asm volatile("" : "+s"(b_), "+s"(g_)); F.bid = b_; F.G = g_; }
          int t_ = threadIdx.x; asm volatile("" : "+v"(t_)); F.tid = t_; F.lane = t_ & 63; F.wave = __builtin_amdgcn_readfirstlane(t_ >> 6);
          const char AS4* ka = (const char AS4*)__builtin_amdgcn_kernarg_segment_ptr();
          F.out = *(float* const AS4*)(ka + 192 + z); F.ws = *(unsigned char* const AS4*)(ka + 200 + z); }
        int l, sub; decode_phase(ph, l, sub);
        const int i = l >> 1; const bool ab = (l & 1) == 0;
        if (l < 0) { p0_prologue(A, F); x0_phase(A, F); }
        else if (l == 4) { final_norm_phase(A, F, F.in(9)); }
        else if (sub == 0) {
            if (ab) { const bf16* Bt = F.pWinab() + (size_t)i * NABP * D;
                pg8::Gemm g{F.pXB(), Bt, M, NABP, D}; pg8::StaticOrder S; S.init(M, NABP, F.G, F.bid);
                pg8::EpiBf16N E{F.pRAW(), NABP, F.pSSQ(), (LAS float*)(F.lds + 131072 + 4096), F.lds + 131072 + 5120, F.in(16) + (size_t)i * 128, 8}; pg8::gemm_phase<pg8::EpiBf16N, pg8::StaticOrder, true, true>(F.lds, g, S, E);
            } else { const bf16* Bt = F.pWinc() + (size_t)i * NCC * D;
                pg8::Gemm g{F.pXB(), Bt, MP, NCC, D}; pg8::TripleOrder S; S.init(F.G, F.bid);
                pg8::EpiBf16CX E{F.pRAW(), F.pSSQ(), (LAS float*)(F.lds + 131072 + 4096), F.lds + 131072 + 5120}; pg8::gemm_phase<pg8::EpiBf16CX, pg8::TripleOrder, true, true>(F.lds, g, S, E);
                asm volatile("s_waitcnt vmcnt(0)" ::: "memory"); __syncthreads();
                for (int trip = F.bid; trip < 256; trip += F.G) { int pm, t; pg8::TripleOrder::owner(trip, pm, t); sconv_local_prompt(A, F, i, pm, t); }
                MicroBf16CX Em{F.pRAW(), F.pSSQ()}; micro_phase(F, F.pXB(), Bt, D, NCC, Em);
                for (int c2 = F.bid; c2 < 256; c2 += F.G) sconv_local_sample(A, F, i, c2 & 15, c2 >> 4);
            }
        }
        else if (sub == 4) {
            pg8::Gemm g{F.pXB(), F.pWup() + (size_t)l * NUP * D, M, NUP, D}; pg8::StaticOrder S; S.init(M, NUP, F.G, F.bid);
            pg8::EpiUpAct E{F.pACT(), F.pSSQ(), F.in(22) + (size_t)l * 3 * DFF, F.in(6) + (size_t)l * NS * 2 * DFF, F.out + O_FC_P + (size_t)l * NB * 2 * DFF, F.out + O_FC_S + (size_t)l * NS * 2 * DFF,
                               F.pFIX(), F.pHALO(), (LAS float*)(F.lds + 131072), (LAS float*)(F.lds + 131072 + 4096), F.lds + 131072 + 5120};
            pg8::gemm_phase<pg8::EpiUpAct, pg8::StaticOrder, true, true>(F.lds, g, S, E);
        }
        else if (sub == 3 || sub == 6) {
            const bf16* Am; const bf16* Bt; int K;
            if (sub == 3) { Am = F.pH(); Bt = (ab ? F.pWoutab() : F.pWoutc()) + (size_t)i * D * D; K = D; }
            else { Am = F.pACT(); Bt = F.pWdown() + (size_t)l * D * DFF; K = DFF; }
            pg8::Gemm g{Am, Bt, MP, D, K}; pg8::StaticOrder S; S.init(MP, D, F.G, F.bid);
            if (sub == 6) {
                pg8::Unit uu; for (int k = 0; S.next(k, uu); ++k) if ((uu.pm & 7) != 0) ffn_fix_panel(A, F, l, uu.pm);
                asm volatile("s_waitcnt vmcnt(0)" ::: "memory"); __syncthreads();
            } else if (!ab) {
                pg8::Unit uu; for (int k = 0; S.next(k, uu); ++k) if ((uu.pm & 7) != 0) sconv_fix_panel(A, F, i, uu.pm);
                asm volatile("s_waitcnt vmcnt(0)" ::: "memory"); __syncthreads();
            }
            pg8::EpiResNorm E{F.pXB(), F.pSSQ(), (LAS float*)(F.lds + 131072)}; pg8::gemm_phase<pg8::EpiResNorm, pg8::StaticOrder, true, true>(F.lds, g, S, E);
        }
        else if (sub == 1) {
            for (int r = 0;; ++r) { const int base = (r * F.G + F.bid) * 2; if (base >= 1024) break; const int unit = base + (F.tid >> 8); dnprep_round(A, F, i, unit, unit < 1024); }
        }
        else if (sub == 2) {
            if (F.bid < 32) scan_block(A, F, i, F.bid);
            else { for (int u = F.bid - 32; u < NS * NH; u += F.G - 32) sample_unit(A, F, i, u);
                   for (int u = F.bid - 32; u < 272 * 4; u += F.G - 32) pool_unit(A, F, i, u >> 2, u & 3);
                   convert_weights(A, F, (F.bid - 32) * NWAVES + F.wave, (F.G - 32) * NWAVES, l == 0 ? 1 : 2); }
        }
        if (ph + 1 < hi) { if (ph == lo) { grid.sync(); if (threadIdx.x == 0) (void)xb_add(&bar.bar[XB_XCNT(bar.x)], 1u); } else xcd_barrier(bar); }
    }
}

extern "C" void kernel_launch(void* const* d_in, const int* in_sizes, int n_in, void* d_out, int out_size, void* d_ws, size_t ws_size, hipStream_t stream) {
    static int grid = 0;
    if (grid == 0) {
        int dev = 0, cus = 0, per_cu = 0;
        (void)hipGetDevice(&dev);
        (void)hipDeviceGetAttribute(&cus, hipDeviceAttributeMultiprocessorCount, dev);
        (void)hipFuncSetAttribute((const void*)mega_fwd, hipFuncAttributeMaxDynamicSharedMemorySize, LDS_BYTES);
        (void)hipOccupancyMaxActiveBlocksPerMultiprocessor(&per_cu, (const void*)mega_fwd, NTHREADS, LDS_BYTES);
        (void)hipGetLastError();
        grid = cus;
        if (n_in != 24 || ws_size < WS_END || per_cu < 1) fprintf(stderr, "kernel_launch: n_in %d ws %zu (need %zu) per_cu %d cus %d\n", n_in, ws_size, (size_t)WS_END, per_cu, cus);
    }
    Args a{};
    for (int i = 0; i < 24; ++i) a.in[i] = (const float*)d_in[i];
    a.out = (float*)d_out; a.ws = (unsigned char*)d_ws; a.ph_lo = 0; a.ph_hi = 1000;
    void* kargs[] = {&a};
    hipError_t e = hipLaunchCooperativeKernel((const void*)mega_fwd, dim3(grid), dim3(NTHREADS), kargs, LDS_BYTES, stream);
    if (e != hipSuccess) fprintf(stderr, "cooperative launch failed: %s (grid %d)\n", hipGetErrorString(e), grid);
}
```

```cpp
#include <hip/hip_runtime.h>
#include <hip/hip_cooperative_groups.h>
#include <cstdio>
#include <cstdint>
namespace cg = cooperative_groups;

#define LAS __attribute__((address_space(3)))
#define GAS __attribute__((address_space(1)))
#define DI __device__ __forceinline__

#define XB_TMO      128
#define XB_XCNT(j)  (256  + 64 * (j))
#define XB_XSUB(j)  (1280 + 64 * (j))
#define XB_XGEN(j)  (2304 + 64 * (j))
#define XB_TOP      3328
#define XB_TOPGEN   3392
#define XCD_BAR_WORDS 3456
#define XB_SPIN_CAP (1u << 18)

__device__ __forceinline__ unsigned xb_ld(unsigned* p)              { return __hip_atomic_load(p, __ATOMIC_RELAXED, __HIP_MEMORY_SCOPE_AGENT); }
__device__ __forceinline__ unsigned xb_add(unsigned* p, unsigned v) { return __hip_atomic_fetch_add(p, v, __ATOMIC_RELAXED, __HIP_MEMORY_SCOPE_AGENT); }
__device__ __forceinline__ unsigned xb_xcc_id() { return (unsigned)__builtin_amdgcn_s_getreg((3 << 11) | 20) & 0xFu; }
#define XB_SPIN(cond, bar) do { unsigned _sp = 0; while (cond) { __builtin_amdgcn_s_sleep(1); \
    if ((++_sp & 255u) == 0u) { if (xb_ld(&(bar)[XB_TMO])) break; if (_sp > XB_SPIN_CAP) { atomicAdd(&(bar)[XB_TMO], 1u); break; } } } } while (0)

struct XcdBarrier { unsigned* bar; unsigned x; volatile LAS unsigned* st; };

__device__ __forceinline__ XcdBarrier xcd_barrier_post(unsigned* bar, volatile LAS unsigned* st) {
    XcdBarrier b; b.bar = bar; b.x = xb_xcc_id(); b.st = st;
    if (threadIdx.x == 0) (void)xb_add(&bar[XB_XCNT(b.x)], 1u);
    return b;
}
__device__ __forceinline__ void xcd_barrier_complete(unsigned* bar, unsigned x, unsigned& nloc, unsigned& nx) {
    const unsigned G = gridDim.x * gridDim.y * gridDim.z;
    unsigned sum, cnt, mine, sp = 0u;
    for (;;) {
        sum = 0u; cnt = 0u; mine = 0u;
#pragma unroll
        for (unsigned j = 0; j < 16; ++j) { const unsigned c = xb_ld(&bar[XB_XCNT(j)]); sum += c; cnt += (c > 0u) ? 1u : 0u; mine = (j == x) ? c : mine; }
        if (sum == G) break;
        __builtin_amdgcn_s_sleep(1);
        if ((++sp & 255u) == 0u) { if (xb_ld(&bar[XB_TMO])) break; if (sp > XB_SPIN_CAP) { atomicAdd(&bar[XB_TMO], 1u); break; } }
    }
    nloc = mine > 0u ? mine : 1u; nx = cnt > 0u ? cnt : 1u;
}
__device__ __forceinline__ void xcd_barrier(const XcdBarrier& b) {
    asm volatile("s_waitcnt vmcnt(0)" ::: "memory");
    __syncthreads();
    if (threadIdx.x == 0) {
        unsigned* bar = b.bar;
        __builtin_amdgcn_s_waitcnt(0);
        unsigned nloc = b.st[0], nx = b.st[1];
        if (nloc == 0u) { xcd_barrier_complete(bar, b.x, nloc, nx); b.st[0] = nloc; b.st[1] = nx; }
        const unsigned old = xb_add(&bar[XB_XSUB(b.x)], 1u);
        const unsigned gen = old / nloc;
        if (old + 1u == (gen + 1u) * nloc) {
            __builtin_amdgcn_fence(__ATOMIC_RELEASE, "agent");
            asm volatile("s_waitcnt vmcnt(0)" ::: "memory");
            const unsigned og = xb_add(&bar[XB_TOP], 1u);
            const unsigned tg = og / nx;
            if (og + 1u == (tg + 1u) * nx) xb_add(&bar[XB_TOPGEN], 1u);
            else XB_SPIN(xb_ld(&bar[XB_TOPGEN]) == tg, bar);
            __builtin_amdgcn_fence(__ATOMIC_ACQUIRE, "agent");
            xb_add(&bar[XB_XGEN(b.x)], 1u);
            asm volatile("s_waitcnt vmcnt(0)" ::: "memory");
        } else {
            XB_SPIN(xb_ld(&bar[XB_XGEN(b.x)]) == gen, bar);
            __builtin_amdgcn_fence(__ATOMIC_ACQUIRE, "agent");
            asm volatile("s_waitcnt vmcnt(0)" ::: "memory");
        }
    }
    __syncthreads();
}

namespace pg8 {
#define PG8_LAS __attribute__((address_space(3)))
typedef unsigned short bf16_t;
typedef short bf16x8 __attribute__((ext_vector_type(8)));
typedef float f32x4 __attribute__((ext_vector_type(4)));
typedef unsigned u32x4 __attribute__((ext_vector_type(4)));
constexpr int BM = 256, BK = 64, HALF = 128, HTB = HALF * BK * 2  , STAGE_BYTES = 8 * HTB, NXCD = 8, WGM = 8;

__host__ __device__ __forceinline__ int lds_byte(int r, int c) { const int st = (r >> 4) * 2 + (c >> 5), rr = r & 15, cc = c & 31, ob = rr * 64 + cc * 2; return st * 1024 + (ob ^ (((ob >> 9) & 1) << 5)); }
__host__ __device__ __forceinline__ void stage_rc(int b, int& R, int& C) { const int st = b / 1024, sb = b % 1024, swz = sb ^ (((sb >> 9) & 1) << 5); R = (st >> 1) * 16 + swz / 64; C = (st & 1) * 32 + (swz % 64) / 2; }
__host__ __device__ __forceinline__ int perm32(int rho) { const int n = rho >> 4, i = rho & 15; return 8 * (i >> 2) + 4 * n + (i & 3); }

struct Unit { int pm, pn; };
struct Gemm { const bf16_t* A; const bf16_t* Bt; int M, N, K; };

struct TripleOrder {
    int G, c;
    __device__ __forceinline__ void init(int G_, int c_) { G = G_; c = c_; }
    __device__ __forceinline__ static void owner(int trip, int& pm, int& t) { const int x = trip & 7, slot = trip >> 3; pm = x * 8 + (slot >> 2); t = slot & 3; }
    __device__ __forceinline__ bool next(int i, Unit& u) const {
        const int trip = c + (i / 3) * G; if (trip >= 256) return false;
        int pm, t; owner(trip, pm, t); const int k = i % 3;
        u.pm = pm; u.pn = k == 0 ? t : 4 + 2 * t + (k - 1); return true;
    }
    __device__ __forceinline__ void a_ready(const Unit&) const {}
    __device__ __forceinline__ void done(const Unit&) const {}
};
struct StaticOrder {
    int nM, nN, nwg, G, c;
    __host__ __device__ __forceinline__ void init(int M, int N, int G_, int c_) { nM = M / BM; nN = N / BM; nwg = nM * nN; G = G_; c = c_; }
    __host__ __device__ __forceinline__ bool next(int i, Unit& u) const {
        const long L = (long)i * G + c; if (L >= nwg) return false;
        int wgid = (int)L; { const int q = nwg / NXCD, r = nwg % NXCD, xcd = wgid % NXCD, off = wgid / NXCD; wgid = (xcd < r ? xcd * (q + 1) : r * (q + 1) + (xcd - r) * q) + off; }
        const int nig = WGM * nN, gid = wgid / nig, fm = gid * WGM, gsz = (nM - fm) < WGM ? (nM - fm) : WGM;
        u.pm = fm + ((wgid % nig) % gsz); u.pn = (wgid % nig) / gsz; return true;
    }
    __device__ __forceinline__ void a_ready(const Unit&) const {}
    __device__ __forceinline__ void done(const Unit&) const {}
};

typedef __bf16 bf16x2_t __attribute__((ext_vector_type(2)));
typedef float f32x2_t __attribute__((ext_vector_type(2)));
__device__ __forceinline__ unsigned cvt_pk_bf16(float lo, float hi) { f32x2_t v = {lo, hi}; return __builtin_bit_cast(unsigned, __builtin_convertvector(v, bf16x2_t)); }

struct EpiBf16 {
    static constexpr bool PERM = true, AFTER_DRAIN = false, INIT = false, PREFETCH = false, MICRO = false;
    bf16_t* O; int ldc;
    __device__ __forceinline__ void operator()(const f32x4 (&acc)[2][2][4][2], const Unit& u, int wr, int wc, int fr, int fq) const {
        const int row0 = u.pm * BM + wr * 64 + fr; const int col0 = u.pn * BM + wc * 32 + 8 * fq;
#pragma unroll
        for (int ai = 0; ai < 2; ++ai)
#pragma unroll
            for (int m = 0; m < 4; ++m) { bf16_t* rowp = O + (size_t)(row0 + ai * HALF + m * 16) * ldc + col0;
#pragma unroll
                for (int bj = 0; bj < 2; ++bj) { const f32x4 v0 = acc[ai][bj][m][0], v1 = acc[ai][bj][m][1];
                    u32x4 w; w.x = cvt_pk_bf16(v0[0], v0[1]); w.y = cvt_pk_bf16(v0[2], v0[3]); w.z = cvt_pk_bf16(v1[0], v1[1]); w.w = cvt_pk_bf16(v1[2], v1[3]);
                    *(u32x4*)(rowp + bj * HALF) = w; } }
    }
};
struct EpiResAdd {
    static constexpr bool PERM = false, AFTER_DRAIN = false, INIT = false, PREFETCH = false, MICRO = false;
    float* X; int ldc;
    __device__ __forceinline__ void operator()(const f32x4 (&acc)[2][2][4][2], const Unit& u, int wr, int wc, int fr, int fq) const {
        const int row0 = u.pm * BM + wr * 64 + fr; const int col0 = u.pn * BM + wc * 32 + 4 * fq;
#pragma unroll
        for (int ai = 0; ai < 2; ++ai)
#pragma unroll
            for (int m = 0; m < 4; ++m) { float* rowp = X + (size_t)(row0 + ai * HALF + m * 16) * ldc + col0;
                f32x4 old[2][2];
#pragma unroll
                for (int bj = 0; bj < 2; ++bj)
#pragma unroll
                    for (int n = 0; n < 2; ++n) old[bj][n] = *(const f32x4*)(rowp + bj * HALF + n * 16);
#pragma unroll
                for (int bj = 0; bj < 2; ++bj)
#pragma unroll
                    for (int n = 0; n < 2; ++n) *(f32x4*)(rowp + bj * HALF + n * 16) = old[bj][n] + acc[ai][bj][m][n]; }
    }
};

__device__ __forceinline__ float dpp_ror1(float x) { return __builtin_bit_cast(float, __builtin_amdgcn_update_dpp(0, __builtin_bit_cast(int, x), 0x121, 0xf, 0xf, true)); }
__device__ __forceinline__ float dpp_ror2(float x) { return __builtin_bit_cast(float, __builtin_amdgcn_update_dpp(0, __builtin_bit_cast(int, x), 0x122, 0xf, 0xf, true)); }
__device__ __forceinline__ void conv_dpp(f32x4& a, const f32x4 g, const f32x4 gp, const f32x4 w1, const f32x4 w0) {
    float a0 = a[0], a1 = a[1], a2 = a[2], a3 = a[3];
    asm("s_nop 1\n\t"
        "v_fmac_f32_dpp %0, %4, %12 row_shr:1 row_mask:0xf bank_mask:0xf\n\t"
        "v_fmac_f32_dpp %1, %5, %13 row_shr:1 row_mask:0xf bank_mask:0xf\n\t"
        "v_fmac_f32_dpp %2, %6, %14 row_shr:1 row_mask:0xf bank_mask:0xf\n\t"
        "v_fmac_f32_dpp %3, %7, %15 row_shr:1 row_mask:0xf bank_mask:0xf\n\t"
        "v_fmac_f32_dpp %0, %4, %16 row_shr:2 row_mask:0xf bank_mask:0xf\n\t"
        "v_fmac_f32_dpp %1, %5, %17 row_shr:2 row_mask:0xf bank_mask:0xf\n\t"
        "v_fmac_f32_dpp %2, %6, %18 row_shr:2 row_mask:0xf bank_mask:0xf\n\t"
        "v_fmac_f32_dpp %3, %7, %19 row_shr:2 row_mask:0xf bank_mask:0xf\n\t"
        "v_fmac_f32_dpp %0, %8, %12 row_shl:15 row_mask:0xf bank_mask:0xf\n\t"
        "v_fmac_f32_dpp %1, %9, %13 row_shl:15 row_mask:0xf bank_mask:0xf\n\t"
        "v_fmac_f32_dpp %2, %10, %14 row_shl:15 row_mask:0xf bank_mask:0xf\n\t"
        "v_fmac_f32_dpp %3, %11, %15 row_shl:15 row_mask:0xf bank_mask:0xf\n\t"
        "v_fmac_f32_dpp %0, %8, %16 row_shl:14 row_mask:0xf bank_mask:0xf\n\t"
        "v_fmac_f32_dpp %1, %9, %17 row_shl:14 row_mask:0xf bank_mask:0xf\n\t"
        "v_fmac_f32_dpp %2, %10, %18 row_shl:14 row_mask:0xf bank_mask:0xf\n\t"
        "v_fmac_f32_dpp %3, %11, %19 row_shl:14 row_mask:0xf bank_mask:0xf"
        : "+v"(a0), "+v"(a1), "+v"(a2), "+v"(a3)
        : "v"(g[0]), "v"(g[1]), "v"(g[2]), "v"(g[3]), "v"(gp[0]), "v"(gp[1]), "v"(gp[2]), "v"(gp[3]),
          "v"(w1[0]), "v"(w1[1]), "v"(w1[2]), "v"(w1[3]), "v"(w0[0]), "v"(w0[1]), "v"(w0[2]), "v"(w0[3]));
    a = (f32x4){a0, a1, a2, a3};
}
__device__ __forceinline__ float row_rstd(const float* ssq, int row) {
    const f32x4 a = *(const f32x4*)(ssq + (size_t)row * 16), b = *(const f32x4*)(ssq + (size_t)row * 16 + 4), c = *(const f32x4*)(ssq + (size_t)row * 16 + 8), d = *(const f32x4*)(ssq + (size_t)row * 16 + 12);
    const float s = ((a[0] + a[1]) + (a[2] + a[3])) + ((b[0] + b[1]) + (b[2] + b[3])) + ((c[0] + c[1]) + (c[2] + c[3])) + ((d[0] + d[1]) + (d[2] + d[3]));
    return rsqrtf(s * (1.0f / 1024.0f) + 1e-6f);
}
__device__ __forceinline__ void ssq_prefetch(const bf16_t* ssq, int pm, PG8_LAS unsigned char* blk) {
    int t = threadIdx.x; asm volatile("" : "+v"(t)); const int w = __builtin_amdgcn_readfirstlane(t >> 6);
    const bf16_t* src = ssq + (size_t)pm * BM * 32 + (size_t)t * 8;
    __builtin_amdgcn_global_load_lds((const unsigned*)src, (PG8_LAS unsigned*)(blk + w * 1024), 16, 0, 0);
    __builtin_amdgcn_global_load_lds((const unsigned*)(src + 4096), (PG8_LAS unsigned*)(blk + 8192 + w * 1024), 16, 0, 0);
}
__device__ __forceinline__ void rstd_table_fill(const PG8_LAS unsigned char* blk, PG8_LAS float* tab) {
    int t = threadIdx.x; asm volatile("" : "+v"(t)); const int row = t >> 1, hf = t & 1;
    const u32x4 a = *(const PG8_LAS u32x4*)(blk + row * 64 + 32 * hf), b = *(const PG8_LAS u32x4*)(blk + row * 64 + 32 * hf + 16);
    float s = 0.f;
#pragma unroll
    for (int e = 0; e < 4; ++e) { s += __uint_as_float(a[e] << 16) + __uint_as_float(a[e] & 0xffff0000u); s += __uint_as_float(b[e] << 16) + __uint_as_float(b[e] & 0xffff0000u); }
    s += __shfl_xor(s, 1);
    if (hf == 0) tab[row] = rsqrtf(s * (1.0f / 1024.0f) + 1e-6f);
}
struct EpiBf16CX {
    static constexpr bool PERM = true, AFTER_DRAIN = false, INIT = false, PREFETCH = true, MICRO = false;
    static constexpr int LDC = 2048;
    bf16_t* O; const bf16_t* ssq; PG8_LAS float* tab; PG8_LAS unsigned char* blk;
    __device__ __forceinline__ void prefetch(const Unit& u) const { ssq_prefetch(ssq, u.pm, blk); }
    __device__ __forceinline__ void operator()(const f32x4 (&acc)[2][2][4][2], const Unit& u, int wr, int wc, int fr, int fq) const {
        rstd_table_fill(blk, tab);
        asm volatile("s_waitcnt lgkmcnt(0)" ::: "memory"); __builtin_amdgcn_s_barrier(); asm volatile("" ::: "memory");
        const int row0 = u.pm * BM + wr * 64 + fr;
        if (u.pn < 4) {
            const int col0 = u.pn * BM + wc * 32 + 8 * fq;
#pragma unroll
            for (int ai = 0; ai < 2; ++ai)
#pragma unroll
                for (int m = 0; m < 4; ++m) { const int row = row0 + ai * HALF + m * 16; const float rs = tab[ai * HALF + wr * 64 + m * 16 + fr]; bf16_t* rowp = O + (size_t)row * LDC + col0;
#pragma unroll
                    for (int bj = 0; bj < 2; ++bj) { const f32x4 v0 = acc[ai][bj][m][0] * rs, v1 = acc[ai][bj][m][1] * rs;
                        u32x4 w; w.x = cvt_pk_bf16(v0[0], v0[1]); w.y = cvt_pk_bf16(v0[2], v0[3]); w.z = cvt_pk_bf16(v1[0], v1[1]); w.w = cvt_pk_bf16(v1[2], v1[3]);
                        *(u32x4*)(rowp + bj * HALF) = w; } }
        } else {
            const int col0 = 1024 + (u.pn - 4) * HALF + wc * 32 + 8 * fq;
#pragma unroll
            for (int ai = 0; ai < 2; ++ai)
#pragma unroll
                for (int m = 0; m < 4; ++m) { const int row = row0 + ai * HALF + m * 16; const float rs = tab[ai * HALF + wr * 64 + m * 16 + fr]; const float r2 = rs * rs;
                    const f32x4 v0 = acc[ai][0][m][0] * acc[ai][1][m][0] * r2, v1 = acc[ai][0][m][1] * acc[ai][1][m][1] * r2;
                    u32x4 w; w.x = cvt_pk_bf16(v0[0], v0[1]); w.y = cvt_pk_bf16(v0[2], v0[3]); w.z = cvt_pk_bf16(v1[0], v1[1]); w.w = cvt_pk_bf16(v1[2], v1[3]);
                    *(u32x4*)(O + (size_t)row * LDC + col0) = w; }
        }
    }
};
struct EpiBf16N {
    static constexpr bool PERM = true, AFTER_DRAIN = false, INIT = false, PREFETCH = true, MICRO = false;
    bf16_t* O; int ldc; const bf16_t* ssq; PG8_LAS float* tab; PG8_LAS unsigned char* blk;
    const float* znw; int zpn;
    __device__ __forceinline__ void prefetch(const Unit& u) const { ssq_prefetch(ssq, u.pm, blk); }
    __device__ __forceinline__ void operator()(const f32x4 (&acc)[2][2][4][2], const Unit& u, int wr, int wc, int fr, int fq) const {
        if ((u.pn == zpn) || (u.pn == zpn + 1)) run<true>(acc, u, wr, wc, fr, fq); else run<false>(acc, u, wr, wc, fr, fq); }
    template <bool zt>
    __device__ __forceinline__ void run(const f32x4 (&acc)[2][2][4][2], const Unit& u, int wr, int wc, int fr, int fq) const {
        f32x4 nw0 = {1.f, 1.f, 1.f, 1.f}, nw1 = nw0;
        if constexpr (zt) { nw0 = *(const f32x4*)(znw + wc * 32 + 8 * fq); nw1 = *(const f32x4*)(znw + wc * 32 + 8 * fq + 4); }
        rstd_table_fill(blk, tab);
        asm volatile("s_waitcnt lgkmcnt(0)" ::: "memory"); __builtin_amdgcn_s_barrier(); asm volatile("" ::: "memory");
        const int row0 = u.pm * BM + wr * 64 + fr; const int col0 = u.pn * BM + wc * 32 + 8 * fq;
#pragma unroll
        for (int ai = 0; ai < 2; ++ai)
#pragma unroll
            for (int m = 0; m < 4; ++m) { const int row = row0 + ai * HALF + m * 16; const float rs = tab[ai * HALF + wr * 64 + m * 16 + fr]; bf16_t* rowp = O + (size_t)row * ldc + col0;
#pragma unroll
                for (int bj = 0; bj < 2; ++bj) { f32x4 v0 = acc[ai][bj][m][0] * rs, v1 = acc[ai][bj][m][1] * rs;
                    if constexpr (zt) {
#pragma unroll
                        for (int j = 0; j < 4; ++j) { v0[j] = v0[j] * __builtin_amdgcn_rcpf(1.f + __builtin_amdgcn_exp2f(-1.4426950408889634f * v0[j])); v1[j] = v1[j] * __builtin_amdgcn_rcpf(1.f + __builtin_amdgcn_exp2f(-1.4426950408889634f * v1[j])); }
                        v0 = v0 * nw0; v1 = v1 * nw1; }
                    u32x4 w; w.x = cvt_pk_bf16(v0[0], v0[1]); w.y = cvt_pk_bf16(v0[2], v0[3]); w.z = cvt_pk_bf16(v1[0], v1[1]); w.w = cvt_pk_bf16(v1[2], v1[3]);
                    *(u32x4*)(rowp + bj * HALF) = w; } }
    }
};
struct EpiResNorm {
    static constexpr bool PERM = true, AFTER_DRAIN = false, INIT = true, PREFETCH = false, MICRO = true;
    bf16_t* XB; bf16_t* SSQ; PG8_LAS float* rsx;
    static __device__ __forceinline__ int xslot(int s_) { return 131072 + 1024 + s_ * 8192; }
    __device__ __forceinline__ void micro_epilogue(const f32x4 (&as)[2], const Unit& u, int wr, int wc, int fr, int fq) const {
        asm volatile("" : "+v"(fr), "+v"(fq));
        const int bjs = u.pm >> 5, row = 16384 + 32 * (u.pm & 31) + 16 * wr + fr;
        bf16_t* p = XB + (size_t)row * 1024 + u.pn * BM + bjs * HALF + wc * 32 + 8 * fq;
        const u32x4 o = *(const u32x4*)p;
        const float t0 = __uint_as_float(o.x << 16) + as[0][0], t1 = __uint_as_float(o.x & 0xffff0000u) + as[0][1], t2 = __uint_as_float(o.y << 16) + as[0][2], t3 = __uint_as_float(o.y & 0xffff0000u) + as[0][3];
        const float t4 = __uint_as_float(o.z << 16) + as[1][0], t5 = __uint_as_float(o.z & 0xffff0000u) + as[1][1], t6 = __uint_as_float(o.w << 16) + as[1][2], t7 = __uint_as_float(o.w & 0xffff0000u) + as[1][3];
        float sq = ((t0 * t0 + t1 * t1) + (t2 * t2 + t3 * t3)) + ((t4 * t4 + t5 * t5) + (t6 * t6 + t7 * t7));
        u32x4 w; w.x = cvt_pk_bf16(t0, t1); w.y = cvt_pk_bf16(t2, t3); w.z = cvt_pk_bf16(t4, t5); w.w = cvt_pk_bf16(t6, t7); *(u32x4*)p = w;
        sq += __shfl_xor(sq, 16); sq += __shfl_xor(sq, 32);
        if (fq == 0) rsx[(wr * 16 + fr) * 4 + wc] = sq;
        asm volatile("s_waitcnt lgkmcnt(0)" ::: "memory"); __builtin_amdgcn_s_barrier(); asm volatile("" ::: "memory");
        if (wc == 0 && fq == 0) { const f32x4 q4 = *(const PG8_LAS f32x4*)(rsx + (wr * 16 + fr) * 4);
            *(unsigned long long*)(SSQ + (size_t)row * 32 + 8 * u.pn + 4 * bjs) = (unsigned long long)cvt_pk_bf16((q4[0] + q4[1]) + (q4[2] + q4[3]), 0.f); }
    }
    __device__ __forceinline__ void init(f32x4 (&acc)[2][2][4][2], const Unit& u, int wr, int wc, int fr, int fq) const {
        const int row0 = u.pm * BM + wr * 64 + fr; const int col0 = u.pn * BM + wc * 32 + 8 * fq;
#pragma unroll
        for (int ai = 0; ai < 2; ++ai)
#pragma unroll
            for (int m = 0; m < 4; ++m)
#pragma unroll
                for (int bj = 0; bj < 2; ++bj) { const u32x4 o = *(const u32x4*)(XB + (size_t)(row0 + ai * HALF + m * 16) * 1024 + col0 + bj * HALF);
                    acc[ai][bj][m][0] = (f32x4){__uint_as_float(o.x << 16), __uint_as_float(o.x & 0xffff0000u), __uint_as_float(o.y << 16), __uint_as_float(o.y & 0xffff0000u)};
                    acc[ai][bj][m][1] = (f32x4){__uint_as_float(o.z << 16), __uint_as_float(o.z & 0xffff0000u), __uint_as_float(o.w << 16), __uint_as_float(o.w & 0xffff0000u)}; }
    }
    __device__ __forceinline__ void operator()(const f32x4 (&acc)[2][2][4][2], const Unit& u, int wr, int wc, int fr, int fq) const {
        asm volatile("" : "+v"(fr), "+v"(fq));
        const int row0 = u.pm * BM + wr * 64 + fr; const int col0 = u.pn * BM + wc * 32 + 8 * fq;
#pragma unroll
        for (int ai = 0; ai < 2; ++ai)
#pragma unroll
            for (int m = 0; m < 4; ++m) { const int row = row0 + ai * HALF + m * 16; bf16_t* rowb = XB + (size_t)row * 1024 + col0;
                float s[2];
#pragma unroll
                for (int bj = 0; bj < 2; ++bj) { const f32x4 a0 = acc[ai][bj][m][0], a1 = acc[ai][bj][m][1];
                    s[bj] = ((a0[0] * a0[0] + a0[1] * a0[1]) + (a0[2] * a0[2] + a0[3] * a0[3])) + ((a1[0] * a1[0] + a1[1] * a1[1]) + (a1[2] * a1[2] + a1[3] * a1[3]));
                    u32x4 w; w.x = cvt_pk_bf16(a0[0], a0[1]); w.y = cvt_pk_bf16(a0[2], a0[3]); w.z = cvt_pk_bf16(a1[0], a1[1]); w.w = cvt_pk_bf16(a1[2], a1[3]); *(u32x4*)(rowb + bj * HALF) = w; }
#pragma unroll
                for (int bj = 0; bj < 2; ++bj) { s[bj] += __shfl_xor(s[bj], 16); s[bj] += __shfl_xor(s[bj], 32); }
                if (fq == 0) { SSQ[(size_t)row * 32 + 8 * u.pn + wc] = (bf16_t)(cvt_pk_bf16(s[0], 0.f) & 0xffffu); SSQ[(size_t)row * 32 + 8 * u.pn + 4 + wc] = (bf16_t)(cvt_pk_bf16(s[1], 0.f) & 0xffffu); } }
    }
};
struct EpiUpAct {
    static constexpr bool PERM = true, AFTER_DRAIN = false, INIT = false, PREFETCH = true, MICRO = false;
    bf16_t* ACT; const bf16_t* ssq; const float* cw; const float* st; float* fc_p; float* fc_s; float* FIX; float* HALO; PG8_LAS float* hx; PG8_LAS float* tab; PG8_LAS unsigned char* blk;
    __device__ __forceinline__ void prefetch(const Unit& u) const { ssq_prefetch(ssq, u.pm, blk); }
    __device__ __forceinline__ void operator()(f32x4 (&acc)[2][2][4][2], const Unit& u, int wr, int wc, int fr, int fq) const {
        if (u.pm >= 64) run<true>(acc, u, wr, wc, fr, fq); else run<false>(acc, u, wr, wc, fr, fq); }
    template <bool sample>
    __device__ __forceinline__ void run(f32x4 (&acc)[2][2][4][2], const Unit& u, int wr, int wc, int fr, int fq) const {
        constexpr int FF = 2816;
        asm volatile("" : "+v"(fr), "+v"(fq));
        const int pmod = u.pm & 7;
        const int L0 = 128 * u.pn + 32 * wc + 8 * fq;
        f32x4 w0[2], w1[2], w2[2];
#pragma unroll
        for (int n = 0; n < 2; ++n) { w0[n] = *(const f32x4*)(cw + L0 + 4 * n); w1[n] = *(const f32x4*)(cw + FF + L0 + 4 * n); w2[n] = *(const f32x4*)(cw + 2 * FF + L0 + 4 * n); }
        rstd_table_fill(blk, tab);
        if (fr >= 14) {
#pragma unroll
            for (int ai = 0; ai < 2; ++ai)
#pragma unroll
                for (int n = 0; n < 2; ++n) *(PG8_LAS f32x4*)(hx + ((((ai * 2 + wr) * 4 + wc) * 2 + (fr - 14)) * 32 + fq * 8 + n * 4)) = acc[ai][0][3][n];
        }
        asm volatile("s_waitcnt lgkmcnt(0)" ::: "memory"); __builtin_amdgcn_s_barrier(); asm volatile("" ::: "memory");
        const int tau = fr & 7;
        f32x4 c1[2], c2[2];
        auto ldstate = [&](int ai_, int m_, f32x4 (&q1)[2], f32x4 (&q2)[2]) {
            const int s = (u.pm * BM + ai_ * HALF + wr * 64 + m_ * 16 + fr - 16384) >> 3; const float* sp = st + (size_t)s * 2 * FF + L0;
#pragma unroll
            for (int n = 0; n < 2; ++n) { q1[n] = *(const f32x4*)(sp + FF + 4 * n); q2[n] = *(const f32x4*)(sp + 4 * n); } };
        if constexpr (sample) ldstate(0, 0, c1, c2);
#pragma unroll
        for (int ai = 0; ai < 2; ++ai) {
            float rs[4];
#pragma unroll
            for (int m = 0; m < 4; ++m) rs[m] = tab[ai * HALF + wr * 64 + m * 16 + fr];
            f32x4 gp[2] = {{0.f, 0.f, 0.f, 0.f}, {0.f, 0.f, 0.f, 0.f}};
            if (!(ai == 0 && wr == 0)) { const int as = wr == 1 ? ai : 0, ws = wr == 1 ? 0 : 1;
                const PG8_LAS float* hp = hx + (((as * 2 + ws) * 4 + wc) * 2) * 32 + fq * 8;
                const int rb = as * HALF + ws * 64 + 48;
                if (fr >= 14) { const float sc = tab[rb + fr]; gp[0] = *(const PG8_LAS f32x4*)(hp + (fr - 14) * 32) * sc; gp[1] = *(const PG8_LAS f32x4*)(hp + (fr - 14) * 32 + 4) * sc; } }
#pragma unroll
            for (int m = 0; m < 4; ++m) {
                const int rt = ai * HALF + wr * 64 + m * 16 + fr, row = u.pm * BM + rt;
                f32x4 n1[2], n2[2];
                if constexpr (sample) { if (!(ai == 1 && m == 3)) ldstate(m == 3 ? ai + 1 : ai, m == 3 ? 0 : m + 1, n1, n2); }
                u32x4 ow;
#pragma unroll
                for (int n = 0; n < 2; ++n) {
                    const int L = L0 + 4 * n;
                    const f32x4 g = acc[ai][0][m][n] * rs[m], v = acc[ai][1][m][n] * rs[m];
                    f32x4 a;
                    if constexpr (sample) {
                        f32x4 p1, p2;
#pragma unroll
                        for (int j = 0; j < 4; ++j) { const float h1 = fr == 15 ? gp[n][j] : g[j], h2 = fr >= 14 ? gp[n][j] : g[j]; p1[j] = dpp_ror1(h1); p2[j] = dpp_ror2(h2); }
                        const int s = (row - 16384) >> 3;
#pragma unroll
                        for (int j = 0; j < 4; ++j) { p2[j] = tau == 0 ? c2[n][j] : (tau == 1 ? c1[n][j] : p2[j]); p1[j] = tau == 0 ? c1[n][j] : p1[j]; }
                        if (tau >= 6) __builtin_nontemporal_store(g, (f32x4*)(fc_s + ((size_t)s * 2 + (tau - 6)) * FF + L));
                        a = w0[n] * p2 + w1[n] * p1 + w2[n] * g;
                    } else {
                        if (ai == 0 && m == 0) { if (rt < 2 && pmod != 0) { float* fx = FIX + ((size_t)(u.pm * 2 + rt) * 2) * FF + L; *(f32x4*)fx = g; *(f32x4*)(fx + FF) = v; } }
                        if (ai == 1 && m == 3) { if (rt >= 254) { if (pmod != 7) *(f32x4*)(HALO + ((size_t)u.pm * 2 + (rt - 254)) * FF + L) = g;
                                                                  else __builtin_nontemporal_store(g, (f32x4*)(fc_p + ((size_t)(u.pm >> 3) * 2 + (rt - 254)) * FF + L)); } }
                        a = w2[n] * g; conv_dpp(a, g, gp[n], w1[n], w0[n]);
                    }
                    const f32x4 t = a * (f32x4){-1.4426950408889634f, -1.4426950408889634f, -1.4426950408889634f, -1.4426950408889634f};
                    f32x4 d = {__builtin_amdgcn_exp2f(t[0]), __builtin_amdgcn_exp2f(t[1]), __builtin_amdgcn_exp2f(t[2]), __builtin_amdgcn_exp2f(t[3])};
                    d = d + (f32x4){1.f, 1.f, 1.f, 1.f};
                    const f32x4 r = {__builtin_amdgcn_rcpf(d[0]), __builtin_amdgcn_rcpf(d[1]), __builtin_amdgcn_rcpf(d[2]), __builtin_amdgcn_rcpf(d[3])};
                    const f32x4 o = a * r * v;
                    if (n == 0) { ow.x = cvt_pk_bf16(o[0], o[1]); ow.y = cvt_pk_bf16(o[2], o[3]); } else { ow.z = cvt_pk_bf16(o[0], o[1]); ow.w = cvt_pk_bf16(o[2], o[3]); }
                    gp[n] = g;
                }
                *(u32x4*)(ACT + (size_t)row * FF + L0) = ow;
                asm volatile("" ::: "memory");
                if constexpr (sample) { if (!(ai == 1 && m == 3)) {
#pragma unroll
                    for (int n = 0; n < 2; ++n) { c1[n] = n1[n]; c2[n] = n2[n]; } } }
            }
        }
    }
};

template <class Epi, class Sched, bool ALIGN_EPI = false, bool SP2 = false>
__device__ __forceinline__ void gemm_phase(PG8_LAS unsigned char* lds, const Gemm g, const Sched& S, const Epi& E) {
    int tid = threadIdx.x; asm volatile("" : "+v"(tid));
    const int wid = __builtin_amdgcn_readfirstlane(tid >> 6), lane = tid & 63, wr = wid >> 2, wc = wid & 3, fr = lane & 15, fq = lane >> 4;
    const int K = g.K, nt = K / BK;
    unsigned voffA[2], voffB[2];
#pragma unroll
    for (int i = 0; i < 2; ++i) { int R, C; stage_rc(tid * 16 + i * 8192, R, C); const int Rb = Epi::PERM ? ((R & ~31) + perm32(R & 31)) : R;
        voffA[i] = (unsigned)(R * K + C) * 2u; voffB[i] = (unsigned)(Rb * K + C) * 2u; }
    const size_t kstep = (size_t)(BK * 2);
    const size_t hstep = (size_t)HALF * K * 2;
    const size_t tstep = 2 * hstep;
    const unsigned ldsw = (unsigned)wid * 1024u;
    const int aoff = lds_byte(wr * 64 + fr, fq * 8), boff = lds_byte(wc * 32 + fr, fq * 8);
#define PG8_SA(b, h) (((b) * 2 + (h)) * HTB)
#define PG8_SB(b, h) ((4 + (b) * 2 + (h)) * HTB)
#define PG8_STAGE(bufoff, gbase, voff) do { _Pragma("unroll") for (int _i = 0; _i < 2; ++_i) \
        __builtin_amdgcn_global_load_lds((const unsigned*)((const char*)(gbase) + (voff)[_i]), (PG8_LAS unsigned*)(lds + (bufoff) + ldsw + _i * 8192), 16, 0, 0); } while (0)
#define PG8_LDA(dst, b, h) do { _Pragma("unroll") for (int m = 0; m < 4; ++m) _Pragma("unroll") for (int k = 0; k < 2; ++k) dst[m][k] = *(const PG8_LAS bf16x8*)(lds + PG8_SA(b, h) + aoff + m * 2048 + k * 1024); } while (0)
#define PG8_LDB(dst, b, h) do { _Pragma("unroll") for (int n = 0; n < 2; ++n) _Pragma("unroll") for (int k = 0; k < 2; ++k) dst[n][k] = *(const PG8_LAS bf16x8*)(lds + PG8_SB(b, h) + boff + n * 2048 + k * 1024); } while (0)
#define PG8_MMA(ai, bj, At, Bt) do { __builtin_amdgcn_s_setprio(1); _Pragma("unroll") for (int m = 0; m < 4; ++m) _Pragma("unroll") for (int n = 0; n < 2; ++n) _Pragma("unroll") for (int k = 0; k < 2; ++k) \
        acc[ai][bj][m][n] = __builtin_amdgcn_mfma_f32_16x16x32_bf16(Bt[n][k], At[m][k], acc[ai][bj][m][n], 0, 0, 0); __builtin_amdgcn_s_setprio(0); } while (0)
#define PG8_WAIT_V(n) asm volatile("s_waitcnt vmcnt(" #n ")" ::: "memory")
#define PG8_WAIT_L(n) asm volatile("s_waitcnt lgkmcnt(" #n ")" ::: "memory")
#define PG8_BAR __builtin_amdgcn_s_barrier()
#define PG8_SCHED __builtin_amdgcn_sched_barrier(0)
    Unit cur, nxt; int ui = 0;
    if (!S.next(0, cur)) return;
    f32x4 acc[2][2][4][2];
    if constexpr (Epi::PREFETCH) E.prefetch(cur);
    if constexpr (Epi::INIT) E.init(acc, cur, wr, wc, fr, fq);
    else {
#pragma unroll
    for (int a = 0; a < 2; ++a)
#pragma unroll
        for (int b = 0; b < 2; ++b)
#pragma unroll
            for (int m = 0; m < 4; ++m)
#pragma unroll
                for (int n = 0; n < 2; ++n) acc[a][b][m][n] = (f32x4){0.f, 0.f, 0.f, 0.f};
    }
    bf16x8 At[4][2], B0[2][2], B1[2][2];
    f32x4 acc_s[2]; int mq = 0, xb = 0; unsigned xso = 0u, xro0 = 0u;
    PG8_LAS unsigned char* const xbase = lds + 131072 + 1024;
#define PG8_MICRO_STAGE(kt) do { __builtin_amdgcn_global_load_lds((const unsigned*)((const char*)g.A + (size_t)(kt) * (BK * 2) + xso), (PG8_LAS unsigned*)(xbase + xb * 8192 + wid * 1024), 16, 0, 0); xb = xb == 2 ? 0 : xb + 1; } while (0)
#define PG8_MICRO_SETUP(u_) do { if constexpr (Epi::MICRO) { mq = (u_).pm >> 5; \
        { const int p_ = tid & 511, r_ = (p_ >> 3) & 31, s_ = p_ & 7; xso = (unsigned)((16384 + 32 * ((u_).pm & 31) + r_) * K + 8 * (s_ ^ (r_ & 7))) * 2u; } \
        xro0 = (unsigned)((16 * wr + fr) * 128 + ((fq ^ (fr & 7)) << 4));   \
        acc_s[0] = (f32x4){0.f, 0.f, 0.f, 0.f}; acc_s[1] = acc_s[0]; xb = 0; } } while (0)
#define PG8_MICRO_MMA1(Bf, slot) do { At[0][0] = *(const PG8_LAS bf16x8*)(xbase + (slot) * 8192 + xro0); At[0][1] = *(const PG8_LAS bf16x8*)(xbase + (slot) * 8192 + (xro0 ^ 64u)); \
        _Pragma("unroll") for (int n_ = 0; n_ < 2; ++n_) _Pragma("unroll") for (int k_ = 0; k_ < 2; ++k_) acc_s[n_] = __builtin_amdgcn_mfma_f32_16x16x32_bf16(Bf[n_][k_], At[0][k_], acc_s[n_], 0, 0, 0); } while (0)
#define PG8_MMA_SP2_MICRO(slot) do { __builtin_amdgcn_s_setprio(1); \
        _Pragma("unroll") for (int m = 0; m < 4; ++m) { \
            _Pragma("unroll") for (int n = 0; n < 2; ++n) _Pragma("unroll") for (int k = 0; k < 2; ++k) { \
                acc[1][0][m][n] = __builtin_amdgcn_mfma_f32_16x16x32_bf16(B0[n][k], At[m][k], acc[1][0][m][n], 0, 0, 0); \
                acc[1][1][m][n] = __builtin_amdgcn_mfma_f32_16x16x32_bf16(B1[n][k], At[m][k], acc[1][1][m][n], 0, 0, 0); } \
            if (m == 0) { At[0][0] = *(const PG8_LAS bf16x8*)(lds + Epi::xslot(slot) + xro0); At[0][1] = *(const PG8_LAS bf16x8*)(lds + Epi::xslot(slot) + (xro0 ^ 64u)); } } \
        if (mq == 0) { _Pragma("unroll") for (int n_ = 0; n_ < 2; ++n_) _Pragma("unroll") for (int k_ = 0; k_ < 2; ++k_) acc_s[n_] = __builtin_amdgcn_mfma_f32_16x16x32_bf16(B0[n_][k_], At[0][k_], acc_s[n_], 0, 0, 0); } \
        else { _Pragma("unroll") for (int n_ = 0; n_ < 2; ++n_) _Pragma("unroll") for (int k_ = 0; k_ < 2; ++k_) acc_s[n_] = __builtin_amdgcn_mfma_f32_16x16x32_bf16(B1[n_][k_], At[0][k_], acc_s[n_], 0, 0, 0); } \
        __builtin_amdgcn_s_setprio(0); } while (0)
#define PG8_MICRO_MMA(slot) do { if constexpr (Epi::MICRO) { if (mq == 0) PG8_MICRO_MMA1(B0, slot); else PG8_MICRO_MMA1(B1, slot); } } while (0)
#define PG8_WAIT_VM(n, nm) do { if constexpr (Epi::MICRO) PG8_WAIT_V(nm); else PG8_WAIT_V(n); } while (0)
    const char* cA = (const char*)g.A + (size_t)cur.pm * tstep; const char* cB = (const char*)g.Bt + (size_t)cur.pn * tstep;
    S.a_ready(cur);
    PG8_MICRO_SETUP(cur);
    int xrd = 0;
    if constexpr (Epi::MICRO) PG8_MICRO_STAGE(0);
    if constexpr (SP2) {
        PG8_STAGE(PG8_SB(0, 0), cB, voffB); PG8_STAGE(PG8_SB(0, 1), cB + hstep, voffB); PG8_STAGE(PG8_SA(0, 0), cA, voffA); PG8_STAGE(PG8_SA(0, 1), cA + hstep, voffA);
        if (wr == 1) PG8_BAR;
        PG8_WAIT_V(2); PG8_BAR;
        PG8_STAGE(PG8_SB(1, 0), cB + kstep, voffB); PG8_STAGE(PG8_SA(1, 0), cA + kstep, voffA); PG8_STAGE(PG8_SB(1, 1), cB + hstep + kstep, voffB);
        PG8_WAIT_V(6); PG8_BAR;
    } else {
        PG8_STAGE(PG8_SB(0, 0), cB, voffB); PG8_STAGE(PG8_SA(0, 0), cA, voffA); PG8_STAGE(PG8_SB(0, 1), cB + hstep, voffB); PG8_STAGE(PG8_SA(0, 1), cA + hstep, voffA);
        if (wr == 1) PG8_BAR;
        PG8_WAIT_V(4); PG8_BAR;
        PG8_STAGE(PG8_SB(1, 0), cB + kstep, voffB); PG8_STAGE(PG8_SA(1, 0), cA + kstep, voffA); PG8_STAGE(PG8_SB(1, 1), cB + hstep + kstep, voffB);
        PG8_WAIT_V(6); PG8_BAR;
    }
    for (;;) {
        const bool has_next = S.next(ui + 1, nxt);
        const char* nA = has_next ? (const char*)g.A + (size_t)nxt.pm * tstep : cA; const char* nB = has_next ? (const char*)g.Bt + (size_t)nxt.pn * tstep : cB;
        for (int t = 0; t < nt; t += 2) {
            const bool last = (t == nt - 2);
            const char* a1 = cA + (size_t)(t + 1) * kstep;
            const char* a2 = last ? nA : cA + (size_t)(t + 2) * kstep; const char* b2 = last ? nB : cB + (size_t)(t + 2) * kstep;
            const char* a3 = a2 + kstep; const char* b3 = b2 + kstep;
            if (last && has_next) S.a_ready(nxt);
            if constexpr (SP2) {
            PG8_LDB(B0, 0, 0); PG8_LDB(B1, 0, 1); PG8_SCHED; PG8_LDA(At, 0, 0); PG8_STAGE(PG8_SA(1, 1), a1 + hstep, voffA);
            if constexpr (Epi::MICRO) PG8_MICRO_STAGE(t + 1);
            PG8_WAIT_VM(8, 9); PG8_WAIT_L(0); PG8_BAR; PG8_MMA(0, 0, At, B0); PG8_MMA(0, 1, At, B1); PG8_BAR; PG8_SCHED;
            PG8_LDA(At, 0, 1); PG8_STAGE(PG8_SB(0, 0), b2, voffB); PG8_STAGE(PG8_SB(0, 1), b2 + hstep, voffB); PG8_STAGE(PG8_SA(0, 0), a2, voffA);
            PG8_WAIT_VM(8, 9); PG8_WAIT_L(0); PG8_BAR;
            if constexpr (Epi::MICRO) { PG8_MMA_SP2_MICRO(xrd); xrd = xrd == 2 ? 0 : xrd + 1; }
            else { PG8_MMA(1, 0, At, B0); PG8_MMA(1, 1, At, B1); }
            PG8_BAR; PG8_SCHED;
            PG8_LDB(B0, 1, 0); PG8_LDB(B1, 1, 1); PG8_SCHED; PG8_LDA(At, 1, 0); PG8_STAGE(PG8_SA(0, 1), a2 + hstep, voffA);
            if constexpr (Epi::MICRO) PG8_MICRO_STAGE(t + 2 < nt ? t + 2 : t + 1);
            PG8_WAIT_VM(8, 9); PG8_WAIT_L(0); PG8_BAR; PG8_MMA(0, 0, At, B0); PG8_MMA(0, 1, At, B1); PG8_BAR; PG8_SCHED;
            PG8_LDA(At, 1, 1); PG8_STAGE(PG8_SB(1, 0), b3, voffB); PG8_STAGE(PG8_SB(1, 1), b3 + hstep, voffB); PG8_STAGE(PG8_SA(1, 0), a3, voffA);
            PG8_WAIT_VM(8, 9); PG8_WAIT_L(0); PG8_BAR;
            if constexpr (Epi::MICRO) { PG8_MMA_SP2_MICRO(xrd); xrd = xrd == 2 ? 0 : xrd + 1; }
            else { PG8_MMA(1, 0, At, B0); PG8_MMA(1, 1, At, B1); }
            PG8_BAR; PG8_SCHED;
            } else {
            PG8_LDB(B0, 0, 0); PG8_SCHED; PG8_LDA(At, 0, 0); PG8_STAGE(PG8_SA(1, 1), a1 + hstep, voffA);
            PG8_WAIT_L(8); PG8_BAR; PG8_WAIT_L(0); PG8_MMA(0, 0, At, B0); PG8_BAR; PG8_SCHED;
            PG8_LDB(B1, 0, 1); PG8_STAGE(PG8_SB(0, 0), b2, voffB);
            PG8_BAR; PG8_WAIT_L(0); PG8_MMA(0, 1, At, B1); PG8_BAR;
            PG8_LDA(At, 0, 1); PG8_STAGE(PG8_SA(0, 0), a2, voffA);
            PG8_BAR; PG8_WAIT_L(0); PG8_MMA(1, 0, At, B0); PG8_BAR; PG8_SCHED;
            PG8_STAGE(PG8_SB(0, 1), b2 + hstep, voffB);
            PG8_WAIT_V(6); PG8_BAR; PG8_MMA(1, 1, At, B1); PG8_BAR;
            PG8_LDB(B0, 1, 0); PG8_SCHED; PG8_LDA(At, 1, 0); PG8_STAGE(PG8_SA(0, 1), a2 + hstep, voffA);
            PG8_WAIT_L(8); PG8_BAR; PG8_WAIT_L(0); PG8_MMA(0, 0, At, B0); PG8_BAR; PG8_SCHED;
            PG8_LDB(B1, 1, 1); PG8_STAGE(PG8_SB(1, 0), b3, voffB);
            PG8_BAR; PG8_WAIT_L(0); PG8_MMA(0, 1, At, B1); PG8_BAR;
            PG8_LDA(At, 1, 1); PG8_STAGE(PG8_SA(1, 0), a3, voffA);
            PG8_BAR; PG8_WAIT_L(0); PG8_MMA(1, 0, At, B0); PG8_BAR; PG8_SCHED;
            PG8_STAGE(PG8_SB(1, 1), b3 + hstep, voffB);
            PG8_WAIT_V(6); PG8_BAR; PG8_MMA(1, 1, At, B1); PG8_BAR;
            }
        }
        if constexpr (ALIGN_EPI) { if (wr == 0) PG8_BAR; }
        if constexpr (Epi::MICRO) E.micro_epilogue(acc_s, cur, wr, wc, fr, fq);
        if constexpr (!Epi::AFTER_DRAIN) { E(acc, cur, wr, wc, fr, fq); S.done(cur); }
        if (!has_next) break;
        if constexpr (Epi::PREFETCH) E.prefetch(nxt);
        if constexpr (Epi::INIT) E.init(acc, nxt, wr, wc, fr, fq);
        else {
#pragma unroll
        for (int a = 0; a < 2; ++a)
#pragma unroll
            for (int b = 0; b < 2; ++b)
#pragma unroll
                for (int m = 0; m < 4; ++m)
#pragma unroll
                    for (int n = 0; n < 2; ++n) acc[a][b][m][n] = (f32x4){0.f, 0.f, 0.f, 0.f};
        }
        cur = nxt; cA = nA; cB = nB; ++ui;
        if constexpr (ALIGN_EPI) { if (wr == 1) PG8_BAR; }
    }
    PG8_WAIT_V(0);
    if constexpr (!ALIGN_EPI) { if (wr == 0) PG8_BAR; }
    PG8_BAR;
    if constexpr (Epi::AFTER_DRAIN) { E.fused(acc, cur, wr, wc, fr, fq, lds, wid, lane); S.done(cur); }
#undef PG8_MICRO_SETUP
#undef PG8_MICRO_STAGE
#undef PG8_MICRO_MMA1
#undef PG8_MMA_SP2_MICRO
#undef PG8_MICRO_MMA
#undef PG8_WAIT_VM
#undef PG8_SA
#undef PG8_SB
#undef PG8_STAGE
#undef PG8_LDA
#undef PG8_LDB
#undef PG8_MMA
#undef PG8_WAIT_V
#undef PG8_WAIT_L
#undef PG8_BAR
#undef PG8_SCHED
}
}

constexpr int NTHREADS = 512, NWAVES = 8;
constexpr int D = 1024, MP = 16384, MS = 1024, M = MP + MS, SEQ = 2048, NB = 8, NS = 128, TS = 8;
constexpr int NAB = 2568, NABP = 2816, DFF = 2816, NUP = 5632, NCC = 3072, NH = 4;
constexpr float EPS = 1e-6f;
constexpr size_t O_Y = 0, O_POOL_P = 17825792, O_POOL_S = 17948672, O_DNC_P = 19914752, O_DNC_S = 19988480, O_DN_P = 21168128, O_DN_S = 22216704,
                 O_SC_P = 38993920, O_SC_S = 39026688, O_FC_P = 39550976, O_FC_S = 39731200;
constexpr size_t MiB = 1u << 20;
constexpr size_t CTL_ZERO_BYTES = 1 * MiB;
constexpr size_t WS_WINAB = 1 * MiB;
constexpr size_t WS_WOUTAB = WS_WINAB + (size_t)2 * NABP * D * 2;
constexpr size_t WS_WINC = WS_WOUTAB + (size_t)2 * D * D * 2;
constexpr size_t WS_WOUTC = WS_WINC + (size_t)2 * NCC * D * 2;
constexpr size_t WS_WUP = WS_WOUTC + (size_t)2 * D * D * 2;
constexpr size_t WS_WDOWN = WS_WUP + (size_t)4 * NUP * D * 2;
constexpr size_t WS_POOLW = WS_WDOWN + (size_t)4 * D * DFF * 2;
constexpr size_t WS_H = WS_POOLW + (size_t)2 * 4 * 128 * 128 * 2;
constexpr size_t WS_XB = WS_H + (size_t)M * D * 2;
constexpr size_t WS_SSQ = WS_XB + (size_t)M * D * 2;
constexpr size_t WS_FIX = WS_SSQ + (size_t)M * 32 * 4;
constexpr size_t WS_HALO = WS_FIX + (size_t)68 * 2 * 2 * DFF * 4;
constexpr size_t WS_RAW = WS_HALO + (size_t)68 * 2 * DFF * 4;
constexpr size_t WS_REC = WS_RAW + (size_t)M * NABP * 2;
constexpr size_t WS_ACT = WS_RAW;
constexpr size_t WS_END = WS_REC + (size_t)1024 * 73984;
static_assert(WS_END >= WS_RAW + (size_t)M * NCC * 2, "pool holds the C-layer projection");
constexpr int REC_NEGW = 0, REC_QG = 16384, REC_AQK = 32768, REC_KDT = 40960, REC_U = 57344, REC_GE = 73728, RECSZ = 73984, REC_STAGE = 57344;
constexpr int CW_BAR = 4096;
constexpr int LDS_BYTES = 163840, LDSCTL_OFF = 163328;

typedef unsigned short bf16;
typedef unsigned v4u __attribute__((ext_vector_type(4)));
typedef unsigned v2u __attribute__((ext_vector_type(2)));
typedef float f32x4 __attribute__((ext_vector_type(4)));
typedef short bf16x8 __attribute__((ext_vector_type(8)));
#define LDS_WAIT() asm volatile("s_waitcnt lgkmcnt(0)" ::: "memory")
DI unsigned pk2(float lo, float hi) { return pg8::cvt_pk_bf16(lo, hi); }
DI unsigned short f2bf(float x) { return __builtin_bit_cast(unsigned short, (__bf16)x); }
DI float bf2f(unsigned short b) { return __uint_as_float((unsigned)b << 16); }
DI float bflo(unsigned w) { return __uint_as_float(w << 16); }
DI float bfhi(unsigned w) { return __uint_as_float(w & 0xffff0000u); }
DI float siluf(float a) { return a * __builtin_amdgcn_rcpf(1.f + __expf(-a)); }
DI float sigmoidf_(float a) { return __builtin_amdgcn_rcpf(1.f + __expf(-a)); }
DI float softplusf_(float a) { return a > 15.f ? a : 0.6931471805599453f * __builtin_amdgcn_logf(1.f + __expf(a)); }
DI int fresh_tid() { int t = threadIdx.x; asm volatile("" : "+v"(t)); return t; }
DI float wave_sum(float v) {
#pragma unroll
    for (int o = 1; o < 64; o <<= 1) v += __shfl_xor(v, o);
    return v;
}
DI float transpose_reduce64_sq(const float (&q)[64], int lane) {
    float v[32];
    { const bool up = (lane & 32) != 0;
#pragma unroll
      for (int r = 0; r < 32; ++r) { const float a = q[r] * q[r], b = q[r + 32] * q[r + 32]; const float send = up ? a : b, keep = up ? b : a; v[r] = keep + __shfl_xor(send, 32); } }
#pragma unroll
    for (int m = 16; m >= 1; m >>= 1) {
        const bool up = (lane & m) != 0;
#pragma unroll
        for (int r = 0; r < m; ++r) {
            const float send = up ? v[r] : v[r + m];
            const float keep = up ? v[r + m] : v[r];
            v[r] = keep + __shfl_xor(send, m);
        }
    }
    return v[0];
}
DI bf16x8 pack8(const f32x4& a, const f32x4& b) { v4u w; w.x = pk2(a[0], a[1]); w.y = pk2(a[2], a[3]); w.z = pk2(b[0], b[1]); w.w = pk2(b[2], b[3]); return __builtin_bit_cast(bf16x8, w); }
#define MFMA16(a, b, c) __builtin_amdgcn_mfma_f32_16x16x32_bf16((a), (b), (c), 0, 0, 0)

struct Args { const float* in[24]; float* out; unsigned char* ws; int ph_lo, ph_hi; };
#define AS4 __attribute__((address_space(4)))
struct Frame {
    LAS unsigned char* lds;
    int tid, lane, wave, G, bid, z;
    unsigned char* ws; float* out;
    DI const float* in(int k) const { const char AS4* ka = (const char AS4*)__builtin_amdgcn_kernarg_segment_ptr(); return *(const float* const AS4*)(ka + 8 * k + z); }
    DI float* pX() const { return out + O_Y; }
    DI bf16* pWinab() const { return (bf16*)(ws + WS_WINAB); }
    DI bf16* pWoutab() const { return (bf16*)(ws + WS_WOUTAB); }
    DI bf16* pWinc() const { return (bf16*)(ws + WS_WINC); }
    DI bf16* pWoutc() const { return (bf16*)(ws + WS_WOUTC); }
    DI bf16* pWup() const { return (bf16*)(ws + WS_WUP); }
    DI bf16* pWdown() const { return (bf16*)(ws + WS_WDOWN); }
    DI bf16* pPoolW() const { return (bf16*)(ws + WS_POOLW); }
    DI bf16* pH() const { return (bf16*)(ws + WS_H); }
    DI bf16* pRAW() const { return (bf16*)(ws + WS_RAW); }
    DI bf16* pACT() const { return (bf16*)(ws + WS_ACT); }
    DI unsigned char* pREC() const { return ws + WS_REC; }
    DI bf16* pXB() const { return (bf16*)(ws + WS_XB); }
    DI bf16* pSSQ() const { return (bf16*)(ws + WS_SSQ); }
    DI float* pFIX() const { return (float*)(ws + WS_FIX); }
    DI float* pHALO() const { return (float*)(ws + WS_HALO); }
};

template <class RowMap>
DI void transpose_item(const float* W, int K, int N, bf16* WT, LAS float* scr, int item, int lane, RowMap rm, const float* kscale) {
    const int nblk = (N + 31) / 32, kb = item / nblk, nb = item % nblk, k0 = 64 * kb, n0 = 32 * nb;
    float ld_[32];
#pragma unroll
    for (int i = 0; i < 32; ++i) { const int kk = 2 * i + (lane >> 5); const int n = n0 + (lane & 31); ld_[i] = n < N ? __builtin_nontemporal_load(&W[(size_t)(k0 + kk) * N + n]) : 0.f; }
#pragma unroll
    for (int i = 0; i < 32; ++i) { const int kk = 2 * i + (lane >> 5); const float sc = kscale ? kscale[k0 + kk] : 1.f; scr[kk * 33 + (lane & 31)] = ld_[i] * sc; }
    LDS_WAIT(); asm volatile("" ::: "memory");
    const int c = lane & 7;
#pragma unroll
    for (int j = 0; j < 4; ++j) { const int n = (lane >> 3) + 8 * j; const LAS float* s = scr + (8 * c) * 33 + n;
        v4u o; o.x = pk2(s[0 * 33], s[1 * 33]); o.y = pk2(s[2 * 33], s[3 * 33]); o.z = pk2(s[4 * 33], s[5 * 33]); o.w = pk2(s[6 * 33], s[7 * 33]);
        if (n0 + n < N) *(v4u*)(WT + (size_t)rm(n0 + n) * K + k0 + 8 * c) = o; }
    LDS_WAIT(); asm volatile("" ::: "memory");
}
struct RmId { DI int operator()(int n) const { return n; } };
struct RmInC {
    DI int operator()(int n) const { if (n < D) return n; const int isx = n >= 2 * D ? 1 : 0; const int c = n - D - isx * D; return D + (c >> 7) * 256 + isx * 128 + (c & 127); } };
struct RmUp {
    DI int operator()(int n) const { const int isv = n >= DFF ? 1 : 0; const int L = n - isv * DFF; return (L >> 7) * 256 + isv * 128 + (L & 127); } };

DI void convert_weights(const Args& A, Frame& F, int gw, int NGW, int part) {
    LAS float* scr = (LAS float*)(F.lds + F.wave * 16384);
    constexpr int I_INAB = (D / 64) * ((NAB + 31) / 32), I_SQ = (D / 64) * (D / 32), I_INC = (D / 64) * (NCC / 32), I_UP = (D / 64) * (NUP / 32), I_DOWN = (DFF / 64) * (D / 32), I_POOL = 2 * 4;
    const int total = part == 0 ? I_INAB + 8 * I_POOL : (part == 1 ? I_INAB + 2 * I_SQ + I_INC + 2 * I_UP + 2 * I_DOWN : 2 * I_SQ + I_INC + 2 * I_UP + 2 * I_DOWN);
    const int lb = part == 2 ? 1 : 0;
    for (int jt = gw; jt < total; jt += NGW) {
        int j = jt;
        if (part == 0) {
            if (j < I_INAB) { transpose_item(F.in(10), D, NAB, F.pWinab(), scr, j, F.lane, RmId(), F.in(7)); continue; }
            j -= I_INAB; { const int mtx = j / I_POOL, r = j % I_POOL; transpose_item(F.in(11) + (size_t)mtx * 128 * 128, 128, 128, F.pPoolW() + (size_t)mtx * 128 * 128, scr, r, F.lane, RmId(), nullptr); continue; }
        }
        if (part == 1) { if (j < I_INAB) { transpose_item(F.in(10) + (size_t)D * NAB, D, NAB, F.pWinab() + (size_t)NABP * D, scr, j, F.lane, RmId(), F.in(7) + (size_t)2 * D); continue; } j -= I_INAB; }
        if (j < I_SQ) { transpose_item(F.in(17) + (size_t)lb * D * D, D, D, F.pWoutab() + (size_t)lb * D * D, scr, j, F.lane, RmId(), nullptr); continue; } j -= I_SQ;
        if (j < I_INC) { transpose_item(F.in(18) + (size_t)lb * D * NCC, D, NCC, F.pWinc() + (size_t)lb * NCC * D, scr, j, F.lane, RmInC(), F.in(7) + (size_t)(2 * lb + 1) * D); continue; } j -= I_INC;
        if (j < I_SQ) { transpose_item(F.in(20) + (size_t)lb * D * D, D, D, F.pWoutc() + (size_t)lb * D * D, scr, j, F.lane, RmId(), nullptr); continue; } j -= I_SQ;
        if (j < 2 * I_UP) { const int l = 2 * lb + j / I_UP, r = j % I_UP; transpose_item(F.in(21) + (size_t)l * D * NUP, D, NUP, F.pWup() + (size_t)l * NUP * D, scr, r, F.lane, RmUp(), F.in(8) + (size_t)l * D); continue; } j -= 2 * I_UP;
        { const int l = 2 * lb + j / I_DOWN, r = j % I_DOWN; transpose_item(F.in(23) + (size_t)l * DFF * D, DFF, D, F.pWdown() + (size_t)l * D * DFF, scr, r, F.lane, RmId(), nullptr); }
    }
}
DI void p0_prologue(const Args& A, Frame& F) {
    convert_weights(A, F, F.bid * NWAVES + F.wave, F.G * NWAVES, 0);
    { const int gt = F.bid * NTHREADS + F.tid, NGT = F.G * NTHREADS; constexpr int PIECES = 2 * (NABP - NAB) * (D / 8);
      for (int p = gt; p < PIECES; p += NGT) { const int l = p / ((NABP - NAB) * (D / 8)), r = p % ((NABP - NAB) * (D / 8));
          const unsigned z_ = (unsigned)F.z;
          *(v4u*)(F.pWinab() + ((size_t)l * NABP + NAB) * D + (size_t)r * 8) = (v4u){z_, z_, z_, z_}; } }
}

DI void x0_phase(const Args& A, Frame& F) {
    const int gw = F.bid * NWAVES + F.wave, NGW = F.G * NWAVES;
    for (int m = gw; m < M; m += NGW) {
        const float* src = m < MP ? F.in(0) + (size_t)m * D : F.in(1) + (size_t)(m - MP) * D;
        const f32x4* xr = (const f32x4*)src + F.lane;
        f32x4 v[4]; float s = 0.f;
#pragma unroll
        for (int j = 0; j < 4; ++j) { v[j] = __builtin_nontemporal_load(&xr[64 * j]); s += (v[j].x * v[j].x + v[j].y * v[j].y) + (v[j].z * v[j].z + v[j].w * v[j].w); }
        s = wave_sum(s);
        v2u* o8 = (v2u*)(F.pXB() + (size_t)m * D) + F.lane;
#pragma unroll
        for (int j = 0; j < 4; ++j) { v2u o; o.x = pk2(v[j].x, v[j].y); o.y = pk2(v[j].z, v[j].w); o8[64 * j] = o; }
        if (F.lane < 32) F.pSSQ()[(size_t)m * 32 + F.lane] = F.lane == 0 ? f2bf(s) : (bf16)0;
    }
}
DI void final_norm_phase(const Args& A, Frame& F, const float* w) {
    const int gw = F.bid * NWAVES + F.wave, NGW = F.G * NWAVES;
    f32x4 wv[4];
#pragma unroll
    for (int j = 0; j < 4; ++j) wv[j] = *((const f32x4*)w + F.lane + 64 * j);
    for (int m = gw; m < M; m += NGW) {
        const v2u* xb = (const v2u*)(F.pXB() + (size_t)m * D) + F.lane;
        f32x4 v[4]; float s = 0.f;
#pragma unroll
        for (int j = 0; j < 4; ++j) { const v2u q = __builtin_nontemporal_load(&xb[64 * j]); v[j] = (f32x4){bflo(q.x), bfhi(q.x), bflo(q.y), bfhi(q.y)}; s += (v[j].x * v[j].x + v[j].y * v[j].y) + (v[j].z * v[j].z + v[j].w * v[j].w); }
        const float rstd = rsqrtf(wave_sum(s) * (1.f / D) + EPS);
        f32x4* xr = (f32x4*)(F.pX() + (size_t)m * D) + F.lane;
#pragma unroll
        for (int j = 0; j < 4; ++j) __builtin_nontemporal_store(v[j] * rstd * wv[j], &xr[64 * j]);
    }
}

DI void ld8(const bf16* p, float (&o)[8]) { const v4u w = *(const v4u*)p; o[0] = bflo(w.x); o[1] = bfhi(w.x); o[2] = bflo(w.y); o[3] = bfhi(w.y); o[4] = bflo(w.z); o[5] = bfhi(w.z); o[6] = bflo(w.w); o[7] = bfhi(w.w); }
DI void ld8f(const float* p, float (&o)[8]) { const f32x4 a = *(const f32x4*)p, b = *((const f32x4*)p + 1); o[0] = a.x; o[1] = a.y; o[2] = a.z; o[3] = a.w; o[4] = b.x; o[5] = b.y; o[6] = b.z; o[7] = b.w; }
DI void st8f_nt(float* p, const float (&o)[8]) { __builtin_nontemporal_store((f32x4){o[0], o[1], o[2], o[3]}, (f32x4*)p); __builtin_nontemporal_store((f32x4){o[4], o[5], o[6], o[7]}, (f32x4*)p + 1); }
DI void st8f(float* p, const float (&o)[8]) { *(f32x4*)p = (f32x4){o[0], o[1], o[2], o[3]}; *((f32x4*)p + 1) = (f32x4){o[4], o[5], o[6], o[7]}; }
DI v4u pk8(const float (&o)[8]) { v4u w; w.x = pk2(o[0], o[1]); w.y = pk2(o[2], o[3]); w.z = pk2(o[4], o[5]); w.w = pk2(o[6], o[7]); return w; }

DI void ffn_fix_panel(const Args& A, Frame& F, int l, int pm) {
    constexpr int OCT = DFF / 8;
    const float* cw = F.in(22) + (size_t)l * 3 * DFF;
    const int tid = fresh_tid();
    if (tid < OCT) {
        const int L = tid * 8;
        float w0[8], w1[8], w2[8]; ld8f(cw + L, w0); ld8f(cw + DFF + L, w1); ld8f(cw + 2 * DFF + L, w2);
        float h0[8], h1[8], g0[8], g1[8], v0[8], v1[8];
        ld8f(F.pHALO() + ((size_t)(pm - 1) * 2 + 0) * DFF + L, h0); ld8f(F.pHALO() + ((size_t)(pm - 1) * 2 + 1) * DFF + L, h1);
        ld8f(F.pFIX() + ((size_t)(pm * 2 + 0) * 2) * DFF + L, g0); ld8f(F.pFIX() + ((size_t)(pm * 2 + 0) * 2 + 1) * DFF + L, v0);
        ld8f(F.pFIX() + ((size_t)(pm * 2 + 1) * 2) * DFF + L, g1); ld8f(F.pFIX() + ((size_t)(pm * 2 + 1) * 2 + 1) * DFF + L, v1);
        float o0[8], o1[8];
#pragma unroll
        for (int e = 0; e < 8; ++e) { const float a0 = w0[e] * h0[e] + w1[e] * h1[e] + w2[e] * g0[e], a1 = w0[e] * h1[e] + w1[e] * g0[e] + w2[e] * g1[e]; o0[e] = siluf(a0) * v0[e]; o1[e] = siluf(a1) * v1[e]; }
        *(v4u*)(F.pACT() + (size_t)(pm * 256) * DFF + L) = pk8(o0);
        *(v4u*)(F.pACT() + (size_t)(pm * 256 + 1) * DFF + L) = pk8(o1);
    }
}
DI void sconv_local_prompt(const Args& A, Frame& F, int i, int pm, int t) {
    const int tid = fresh_tid(); const int c = 256 * t + 8 * (tid & 31);
    const float* cw = F.in(19) + (size_t)i * 3 * D;
    float w0[8], w1[8], w2[8]; ld8f(cw + c, w0); ld8f(cw + D + c, w1); ld8f(cw + 2 * D + c, w2);
    const bool start = (pm & 7) == 0;
#pragma unroll 1
    for (int k0 = 0; k0 < 16; k0 += 4) {
        v4u qb[4], q0[4], q1[4], q2[4];
#pragma unroll
        for (int u = 0; u < 4; ++u) { const int r = (tid >> 5) + 16 * (k0 + u); const bf16* p = F.pRAW() + (size_t)(pm * 256 + r) * 2048 + c;
            qb[u] = *(const v4u*)p; q0[u] = *(const v4u*)(p + D);
            q1[u] = r >= 1 ? *(const v4u*)(p + D - 2048) : (v4u){0u, 0u, 0u, 0u};
            q2[u] = r >= 2 ? *(const v4u*)(p + D - 4096) : (v4u){0u, 0u, 0u, 0u}; }
#pragma unroll
        for (int u = 0; u < 4; ++u) { const int r = (tid >> 5) + 16 * (k0 + u), m = pm * 256 + r, pos = m & (SEQ - 1);
            const unsigned wb[4] = {qb[u].x, qb[u].y, qb[u].z, qb[u].w}, wg0[4] = {q0[u].x, q0[u].y, q0[u].z, q0[u].w}, wg1[4] = {q1[u].x, q1[u].y, q1[u].z, q1[u].w}, wg2[4] = {q2[u].x, q2[u].y, q2[u].z, q2[u].w};
            float o[8], g0[8];
#pragma unroll
            for (int e = 0; e < 4; ++e) { g0[2 * e] = bflo(wg0[e]); g0[2 * e + 1] = bfhi(wg0[e]);
                o[2 * e] = bflo(wb[e]) * (w0[2 * e] * bflo(wg2[e]) + w1[2 * e] * bflo(wg1[e]) + w2[2 * e] * g0[2 * e]);
                o[2 * e + 1] = bfhi(wb[e]) * (w0[2 * e + 1] * bfhi(wg2[e]) + w1[2 * e + 1] * bfhi(wg1[e]) + w2[2 * e + 1] * g0[2 * e + 1]); }
            if (pos >= SEQ - 2) st8f_nt(F.out + O_SC_P + ((size_t)(i * NB + (m >> 11)) * 2 + (pos - (SEQ - 2))) * D + c, g0);
            if (r >= 2 || start) *(v4u*)(F.pH() + (size_t)m * D + c) = pk8(o); }
    }
}
DI void sconv_fix_panel(const Args& A, Frame& F, int i, int pm) {
    const int tid = fresh_tid();
    if (tid < 256) { const int c = 8 * (tid & 127), m = pm * 256 + (tid >> 7);
        const float* cw = F.in(19) + (size_t)i * 3 * D;
        float w0[8], w1[8], w2[8]; ld8f(cw + c, w0); ld8f(cw + D + c, w1); ld8f(cw + 2 * D + c, w2);
        float bb[8], g0[8], g1[8], g2[8]; ld8(F.pRAW() + (size_t)m * 2048 + c, bb); ld8(F.pRAW() + (size_t)m * 2048 + D + c, g0);
        ld8(F.pRAW() + (size_t)(m - 1) * 2048 + D + c, g1); ld8(F.pRAW() + (size_t)(m - 2) * 2048 + D + c, g2);
        float o[8];
#pragma unroll
        for (int e = 0; e < 8; ++e) o[e] = bb[e] * (w0[e] * g2[e] + w1[e] * g1[e] + w2[e] * g0[e]);
        *(v4u*)(F.pH() + (size_t)m * D + c) = pk8(o); }
}
DI void sconv_local_sample(const Args& A, Frame& F, int i, int rb, int cq) {
    const int tid = fresh_tid(); const int c = 64 * cq + 8 * (tid & 7), r = tid >> 3, m = MP + 64 * rb + r, s = (64 * rb + r) >> 3, tau = r & 7;
    const float* cw = F.in(19) + (size_t)i * 3 * D;
    const float* sp = F.in(5) + (size_t)i * NS * 2 * D + (size_t)s * 2 * D + c;
    float w0[8], w1[8], w2[8]; ld8f(cw + c, w0); ld8f(cw + D + c, w1); ld8f(cw + 2 * D + c, w2);
    float bb[8], g0[8], p1[8], p2[8]; ld8(F.pRAW() + (size_t)m * 2048 + c, bb); ld8(F.pRAW() + (size_t)m * 2048 + D + c, g0);
    if (tau >= 1) ld8(F.pRAW() + (size_t)(m - 1) * 2048 + D + c, p1); else ld8f(sp + D, p1);
    if (tau >= 2) ld8(F.pRAW() + (size_t)(m - 2) * 2048 + D + c, p2); else ld8f(sp + (tau == 0 ? 0 : D), p2);
    if (tau >= 6) st8f_nt(F.out + O_SC_S + ((size_t)(i * NS + s) * 2 + (tau - 6)) * D + c, g0);
    float o[8];
#pragma unroll
    for (int e = 0; e < 8; ++e) o[e] = bb[e] * (w0[e] * p2[e] + w1[e] * p1[e] + w2[e] * g0[e]);
    *(v4u*)(F.pH() + (size_t)m * D + c) = pk8(o);
}
DI void pool_unit(const Args& A, Frame& F, int li, int rb, int g) {
    const int tid_ = fresh_tid(); const int lane_ = tid_ & 63, wave_ = __builtin_amdgcn_readfirstlane(tid_ >> 6);
    const int w = 2 << g;
    LAS unsigned short* Y = (LAS unsigned short*)F.lds;
    const int cq = tid_ & 31, rg = tid_ >> 5;
    const int c0 = 128 * g + 4 * cq, r0 = 4 * rg, m0 = 64 * rb + r0;
    const bool prompt = rb < 256;
    const int pbase = prompt ? ((rb & 31) * 64 + r0) : 0;
    const int s = prompt ? 0 : (m0 - MP) >> 3, tau0 = prompt ? 0 : (m0 - MP) & 7;
    const float* stp = F.in(2) + ((size_t)(li * NS + s) * 15) * 512;
    const int fr = lane_ & 15, fq = lane_ >> 4, wv = wave_;
    const bf16* wt = F.pPoolW() + ((size_t)(li * 4 + g) * 128 + 16 * wv + fr) * 128 + 8 * fq;
    bf16x8 Bw[4];
#pragma unroll
    for (int ks = 0; ks < 4; ++ks) Bw[ks] = *(const bf16x8*)(wt + 32 * ks);
    const f32x4 ps = *(const f32x4*)(F.in(12) + (size_t)li * 512 + 128 * g + 16 * wv + 4 * fq);
    float vals[19][4];
#pragma unroll
    for (int e = 0; e < 19; ++e) {
        const int off = e - 15;
        float x0 = 0.f, x1 = 0.f, x2 = 0.f, x3 = 0.f;
        if (off >= 1 - w) {
            if (prompt) { if (pbase + off >= 0) { const v2u q = *(const v2u*)(F.pRAW() + (size_t)(m0 + off) * NABP + c0); x0 = bflo(q.x); x1 = bfhi(q.x); x2 = bflo(q.y); x3 = bfhi(q.y); } }
            else { const int tp = tau0 + off;
                if (tp >= 0) { const v2u q = *(const v2u*)(F.pRAW() + (size_t)(m0 + off) * NABP + c0); x0 = bflo(q.x); x1 = bfhi(q.x); x2 = bflo(q.y); x3 = bfhi(q.y); }
                else { const f32x4 q = __builtin_nontemporal_load((const f32x4*)(stp + (size_t)(15 + tp) * 512 + c0)); x0 = q.x; x1 = q.y; x2 = q.z; x3 = q.w; } }
        }
        vals[e][0] = x0; vals[e][1] = x1; vals[e][2] = x2; vals[e][3] = x3;
    }
    float S[4] = {0.f, 0.f, 0.f, 0.f};
#pragma unroll
    for (int d = 0; d < 16; ++d) if (d < w) {
#pragma unroll
        for (int k = 0; k < 4; ++k) S[k] += vals[15 - d][k]; }
#pragma unroll
    for (int rr = 0; rr < 4; ++rr) {
        if (rr > 0) {
#pragma unroll
            for (int k = 0; k < 4; ++k) { float old = 0.f;
#pragma unroll
                for (int e = 0; e < 19; ++e) if (e == 15 + rr - w) old = vals[e][k];
                S[k] += vals[15 + rr][k] - old; } }
        const int cnt = prompt ? ((pbase + rr + 1) < w ? (pbase + rr + 1) : w) : w;
        const float inv = 1.f / (float)cnt;
        v2u o; o.x = pk2(S[0] * inv - vals[15 + rr][0], S[1] * inv - vals[15 + rr][1]); o.y = pk2(S[2] * inv - vals[15 + rr][2], S[3] * inv - vals[15 + rr][3]);
        *(LAS v2u*)(Y + (r0 + rr) * 136 + 4 * cq) = o;
    }
    if (prompt) { if ((rb & 31) == 31 && r0 >= 48) {
#pragma unroll
            for (int rr = 0; rr < 4; ++rr) { const int r = r0 + rr; if (r >= 49)
                *(f32x4*)(F.out + O_POOL_P + ((size_t)((li * NB + (rb >> 5)) * 15 + (r - 49))) * 512 + c0) = (f32x4){vals[15 + rr][0], vals[15 + rr][1], vals[15 + rr][2], vals[15 + rr][3]}; } }
    } else {
        float* op = F.out + O_POOL_S + ((size_t)(li * NS + s) * 15) * 512 + c0;
        if (tau0 == 0) {
#pragma unroll
            for (int j = 0; j < 7; ++j) __builtin_nontemporal_store(__builtin_nontemporal_load((const f32x4*)(stp + (size_t)(8 + j) * 512 + c0)), (f32x4*)(op + (size_t)j * 512));
        }
#pragma unroll
        for (int rr = 0; rr < 4; ++rr) __builtin_nontemporal_store((f32x4){vals[15 + rr][0], vals[15 + rr][1], vals[15 + rr][2], vals[15 + rr][3]}, (f32x4*)(op + (size_t)(7 + tau0 + rr) * 512));
    }
    __syncthreads();
#pragma unroll
    for (int mi = 0; mi < 4; ++mi) {
        f32x4 acc = {0.f, 0.f, 0.f, 0.f};
#pragma unroll
        for (int ks = 0; ks < 4; ++ks) { const bf16x8 ya = *(const LAS bf16x8*)(Y + (16 * mi + fr) * 136 + 32 * ks + 8 * fq); acc = MFMA16(Bw[ks], ya, acc); }
        v2u o; o.x = pk2(acc[0] * ps[0], acc[1] * ps[1]); o.y = pk2(acc[2] * ps[2], acc[3] * ps[3]);
        *(v2u*)(F.pH() + (size_t)(64 * rb + 16 * mi + fr) * D + 128 * g + 16 * wv + 4 * fq) = o;
    }
    __syncthreads();
}
typedef float f32x2 __attribute__((ext_vector_type(2)));
template <int I, int K>
DI void subst_ld(f32x4 (&dst)[4], const LAS float* Lm) {
#pragma unroll
    for (int v = 0; v < 4; ++v) if (16 * K + 4 * v < I) dst[v] = *(const LAS f32x4*)(Lm + I * 68 + 16 * K + 4 * v);
}
template <int I, int K, int Q>
DI void subst_step(f32x2 (&cx)[32], f32x2 (&cy)[32], f32x4 (&R)[3][4], const LAS float* Lm, f32x2& ax, f32x2& ay) {
    constexpr int N = (I + 15) >> 4;
    constexpr int i1 = (K + 1 < N) ? I : I + 1, k1 = (K + 1 < N) ? K + 1 : 0;
    constexpr int n1 = (i1 + 15) >> 4;
    constexpr int i2 = (k1 + 1 < n1) ? i1 : i1 + 1, k2 = (k1 + 1 < n1) ? k1 + 1 : 0;
    if constexpr (i2 < 64) subst_ld<i2, k2>(R[(Q + 2) % 3], Lm);
    __builtin_amdgcn_sched_barrier(0);
    if constexpr (K == 0) { ax = (f32x2){cx[I >> 1][I & 1], 0.f}; ay = (f32x2){cy[I >> 1][I & 1], 0.f}; }
#pragma unroll
    for (int v = 0; v < 4; ++v)
#pragma unroll
        for (int p = 0; p < 2; ++p) { const int j0 = 16 * K + 4 * v + 2 * p;
            if (j0 + 1 < I) { const f32x2 ll = {R[Q % 3][v][2 * p], R[Q % 3][v][2 * p + 1]}; ax -= ll * cx[j0 >> 1]; ay -= ll * cy[j0 >> 1]; }
            else if (j0 < I) { const float l = R[Q % 3][v][2 * p]; ax[0] -= l * cx[j0 >> 1][0]; ay[0] -= l * cy[j0 >> 1][0]; } }
    if constexpr (K + 1 == N) { cx[I >> 1][I & 1] = ax[0] + ax[1]; cy[I >> 1][I & 1] = ay[0] + ay[1]; }
    __builtin_amdgcn_sched_barrier(0);
    if constexpr (i1 < 64) subst_step<i1, k1, Q + 1>(cx, cy, R, Lm, ax, ay);
}
constexpr int DP_R0 = 0, DP_R1 = 17408, DP_R2 = 35840, DP_R3 = 53248, DP_GS = 70656, DP_HALF = 73728;
DI void dnprep_round(const Args& A, Frame& F, int li, int unit, bool active) {
    const int tid_ = fresh_tid(); const int half = tid_ >> 8, ht = tid_ & 255, hw = __builtin_amdgcn_readfirstlane(ht >> 6), lane = tid_ & 63;
    LAS unsigned char* LB = F.lds + half * DP_HALF;
    LAS float* GS = (LAS float*)(LB + DP_GS);
    const int n = unit & 31, h = (unit >> 5) & 3, b = unit >> 7;
    const int tb = b * SEQ + n * 64;
    unsigned char* rec = F.pREC() + (size_t)unit * RECSZ;
    if (active) {
        if (ht < 192) {
            const int cq = ht % 96, seg = ht / 96, part = cq >> 5, c4 = (cq & 31) * 4;
            const int ch = part * 512 + 128 * h + c4;
            const float* cw = F.in(13) + (size_t)li * 4 * 1536 + ch;
            const f32x4 w0 = *(const f32x4*)cw, w1 = *(const f32x4*)(cw + 1536), w2 = *(const f32x4*)(cw + 2 * 1536), w3 = *(const f32x4*)(cw + 3 * 1536);
            const bf16* rp = F.pRAW() + (size_t)(tb + 32 * seg) * NABP + 512 + ch;
            f32x4 h3 = {0.f, 0.f, 0.f, 0.f}, h2 = h3, h1 = h3;
            if (!(n == 0 && seg == 0)) { const v2u a = *(const v2u*)(rp - 3 * NABP), b2 = *(const v2u*)(rp - 2 * NABP), c2 = *(const v2u*)(rp - NABP);
                h3 = (f32x4){bflo(a.x), bfhi(a.x), bflo(a.y), bfhi(a.y)}; h2 = (f32x4){bflo(b2.x), bfhi(b2.x), bflo(b2.y), bfhi(b2.y)}; h1 = (f32x4){bflo(c2.x), bfhi(c2.x), bflo(c2.y), bfhi(c2.y)}; }
            LAS unsigned char* tile = LB + (part == 0 ? DP_R0 : (part == 1 ? DP_R1 : DP_R2));
            float* dnc = F.out + O_DNC_P + ((size_t)(li * NB + b) * 3) * 1536 + ch;
            v2u rawv[32];
#pragma unroll
            for (int r = 0; r < 32; ++r) rawv[r] = __builtin_nontemporal_load((const v2u*)(rp + (size_t)r * NABP));
#pragma unroll
            for (int r = 0; r < 32; ++r) {
                const v2u cu = rawv[r];
                const f32x4 c = {bflo(cu.x), bfhi(cu.x), bflo(cu.y), bfhi(cu.y)};
                const f32x4 a = w0 * h3 + w1 * h2 + w2 * h1 + w3 * c;
                v2u o; o.x = pk2(a[0] * __builtin_amdgcn_rcpf(1.f + __expf(-a[0])), a[1] * __builtin_amdgcn_rcpf(1.f + __expf(-a[1])));
                o.y = pk2(a[2] * __builtin_amdgcn_rcpf(1.f + __expf(-a[2])), a[3] * __builtin_amdgcn_rcpf(1.f + __expf(-a[3])));
                *(LAS v2u*)(tile + ((32 * seg + r) * 136 + c4) * 2) = o;
                if (n == 31 && seg == 1 && r >= 29) *(f32x4*)(dnc + (size_t)(r - 29) * 1536) = c;
                h3 = h2; h2 = h1; h1 = c;
            }
        } else {
            const float bl = bf2f(F.pRAW()[(size_t)(tb + lane) * NABP + 2560 + h]), al = bf2f(F.pRAW()[(size_t)(tb + lane) * NABP + 2564 + h]);
            const float beta = sigmoidf_(bl);
            const float g = -__expf(F.in(14)[li * 4 + h]) * softplusf_(al + F.in(15)[li * 4 + h]);
            float gc = g;
#pragma unroll
            for (int o = 1; o < 64; o <<= 1) { const float t = __int_as_float(__builtin_amdgcn_ds_bpermute((lane >= o ? lane - o : lane) << 2, __float_as_int(gc))); if (lane >= o) gc += t; }
            const float gcl = __int_as_float(__builtin_amdgcn_readlane(__float_as_int(gc), 63));
            GS[lane] = beta; GS[64 + lane] = gc; GS[128 + lane] = beta * __expf(gc); GS[192 + lane] = __expf(gcl - gc); if (lane == 63) GS[256] = gc;
        }
    }
    __syncthreads();
    if (active) {
        const int row = ht >> 2, wk = (ht >> 1) & 1, hf = ht & 1;
        LAS unsigned char* p = LB + (wk ? DP_R1 : DP_R0) + (row * 136 + 64 * hf) * 2;
        v4u x[8]; float ss = 0.f;
#pragma unroll
        for (int e = 0; e < 8; ++e) { x[e] = *(const LAS v4u*)(p + 16 * e);
            const float a0 = bflo(x[e].x), a1 = bfhi(x[e].x), a2 = bflo(x[e].y), a3 = bfhi(x[e].y), a4 = bflo(x[e].z), a5 = bfhi(x[e].z), a6 = bflo(x[e].w), a7 = bfhi(x[e].w);
            ss += ((a0 * a0 + a1 * a1) + (a2 * a2 + a3 * a3)) + ((a4 * a4 + a5 * a5) + (a6 * a6 + a7 * a7)); }
        ss += __shfl_xor(ss, 1);
        const float rn = rsqrtf(ss + EPS) * (wk ? 1.f : 0.08838834764831845f);
#pragma unroll
        for (int e = 0; e < 8; ++e) { v4u o; o.x = pk2(bflo(x[e].x) * rn, bfhi(x[e].x) * rn); o.y = pk2(bflo(x[e].y) * rn, bfhi(x[e].y) * rn); o.z = pk2(bflo(x[e].z) * rn, bfhi(x[e].z) * rn); o.w = pk2(bflo(x[e].w) * rn, bfhi(x[e].w) * rn);
            *(LAS v4u*)(p + 16 * e) = o; }
    }
    __syncthreads();
    if (active) {
        const int mi = hw, fr = lane & 15, fq = lane >> 4, i = 16 * mi + fr;
        const float gci = GS[64 + i], bi = GS[i];
        bf16x8 Yq[4], Yk[4];
#pragma unroll
        for (int ks = 0; ks < 4; ++ks) { Yq[ks] = *(const LAS bf16x8*)(LB + DP_R0 + (i * 136 + 32 * ks + 8 * fq) * 2); Yk[ks] = *(const LAS bf16x8*)(LB + DP_R1 + (i * 136 + 32 * ks + 8 * fq) * 2); }
        v2u aq[4];
#pragma unroll
        for (int nj = 0; nj < 4; ++nj) {
            aq[nj] = (v2u){0u, 0u};
            if (nj <= mi) {
                f32x4 accQ = {0.f, 0.f, 0.f, 0.f}, accK = {0.f, 0.f, 0.f, 0.f};
#pragma unroll
                for (int ks = 0; ks < 4; ++ks) { const bf16x8 X = *(const LAS bf16x8*)(LB + DP_R1 + ((16 * nj + fr) * 136 + 32 * ks + 8 * fq) * 2); accQ = MFMA16(X, Yq[ks], accQ); accK = MFMA16(X, Yk[ks], accK); }
                float a4[4]; f32x4 l4;
#pragma unroll
                for (int r = 0; r < 4; ++r) { const int j = 16 * nj + 4 * fq + r; const float gcj = GS[64 + j];
                    const float dec = (j <= i) ? __expf(gci - gcj) : 0.f;
                    a4[r] = accQ[r] * dec; l4[r] = (j < i) ? bi * accK[r] * dec : 0.f; }
                aq[nj] = (v2u){pk2(a4[0], a4[1]), pk2(a4[2], a4[3])};
                *(LAS f32x4*)(LB + DP_R3 + (i * 68 + 16 * nj + 4 * fq) * 4) = l4;
            }
        }
#pragma unroll
        for (int js = 0; js < 2; ++js) if (!(js == 1 && mi < 2)) __builtin_nontemporal_store((v4u){aq[2 * js].x, aq[2 * js].y, aq[2 * js + 1].x, aq[2 * js + 1].y}, (v4u*)(rec + REC_AQK + (size_t)((mi * 2 + js) * 64 + lane) * 16));
    }
    const int aw = hw - 2 * half; const bool sact = active && (aw == 0 || aw == 1); const bool kthr = aw == 0;
    f32x2 cx[32], cy[32];
    if (sact) {
        const LAS unsigned* tp = (const LAS unsigned*)(LB + (kthr ? DP_R1 : DP_R2)) + lane;
        const LAS float* cf = GS + (kthr ? 128 : 0);
#pragma unroll
        for (int i = 0; i < 64; ++i) { const unsigned q = tp[i * 68]; const float sc = cf[i]; cx[i >> 1][i & 1] = bflo(q) * sc; cy[i >> 1][i & 1] = bfhi(q) * sc; }
    }
    __syncthreads();
    if (sact) {
        const LAS float* Lm = (const LAS float*)(LB + DP_R3);
        asm volatile("" : "+v"(Lm));
        f32x4 R[3][4]; f32x2 ax, ay;
        subst_ld<1, 0>(R[0], Lm); subst_ld<2, 0>(R[1], Lm);
        __builtin_amdgcn_sched_barrier(0);
        subst_step<1, 0, 0>(cx, cy, R, Lm, ax, ay);
    } else if (active) {
        const int it = (half == 0 ? hw - 2 : hw) * 64 + lane;
#pragma unroll 1
        for (int e = 0; e < 8; ++e) { const int p = it + 128 * e; const int fr_ = p >> 6, ln = p & 63, qq = ln >> 4, cc = ln & 15;
            { const int mi = fr_ >> 2, ks = fr_ & 3, i = 16 * mi + cc, ka = 32 * ks + 4 * qq; const float gm = __expf(GS[64 + i]);
              const v2u a = *(const LAS v2u*)(LB + DP_R0 + (i * 136 + ka) * 2), bq = *(const LAS v2u*)(LB + DP_R0 + (i * 136 + ka + 16) * 2);
              __builtin_nontemporal_store((v4u){pk2(bflo(a.x) * gm, bfhi(a.x) * gm), pk2(bflo(a.y) * gm, bfhi(a.y) * gm), pk2(bflo(bq.x) * gm, bfhi(bq.x) * gm), pk2(bflo(bq.y) * gm, bfhi(bq.y) * gm)}, (v4u*)(rec + REC_QG + (size_t)p * 16)); }
            { const int kf = fr_ >> 1, js = fr_ & 1, k = 16 * kf + cc, ia = 32 * js + 4 * qq;
              const LAS unsigned short* kp = (const LAS unsigned short*)(LB + DP_R1) + k;
              float v[8];
#pragma unroll
              for (int j = 0; j < 8; ++j) { const int i = ia + (j & 3) + 16 * (j >> 2); v[j] = bf2f(kp[i * 136]) * GS[192 + i]; }
              __builtin_nontemporal_store((v4u){pk2(v[0], v[1]), pk2(v[2], v[3]), pk2(v[4], v[5]), pk2(v[6], v[7])}, (v4u*)(rec + REC_KDT + (size_t)p * 16)); }
        }
    }
    __syncthreads();
    if (sact) {
        if (kthr) {
#pragma unroll
            for (int i = 0; i < 64; ++i) ((LAS unsigned*)(LB + DP_R0))[i * 68 + lane] = pk2(-cx[i >> 1][i & 1], -cy[i >> 1][i & 1]);
        } else {
#pragma unroll
            for (int j = 0; j < 8; ++j) {
                *(LAS v4u*)(LB + DP_R1 + ((2 * lane) * 72 + 8 * j) * 2) = (v4u){pk2(cx[4 * j][0], cx[4 * j][1]), pk2(cx[4 * j + 1][0], cx[4 * j + 1][1]), pk2(cx[4 * j + 2][0], cx[4 * j + 2][1]), pk2(cx[4 * j + 3][0], cx[4 * j + 3][1])};
                *(LAS v4u*)(LB + DP_R1 + ((2 * lane + 1) * 72 + 8 * j) * 2) = (v4u){pk2(cy[4 * j][0], cy[4 * j][1]), pk2(cy[4 * j + 1][0], cy[4 * j + 1][1]), pk2(cy[4 * j + 2][0], cy[4 * j + 2][1]), pk2(cy[4 * j + 3][0], cy[4 * j + 3][1])};
            }
        }
    }
    __syncthreads();
    if (active) {
#pragma unroll 1
        for (int e = 0; e < 4; ++e) { const int p = ht + 256 * e; const int fr_ = p >> 6, ln = p & 63, qq = ln >> 4, cc = ln & 15;
            const int mi = fr_ >> 2, ks = fr_ & 3, i = 16 * mi + cc, ka = 32 * ks + 4 * qq;
            const v2u a = *(const LAS v2u*)(LB + DP_R0 + (i * 136 + ka) * 2), bq = *(const LAS v2u*)(LB + DP_R0 + (i * 136 + ka + 16) * 2);
            __builtin_nontemporal_store((v4u){a.x, a.y, bq.x, bq.y}, (v4u*)(rec + REC_NEGW + (size_t)p * 16)); }
#pragma unroll 1
        for (int e = 0; e < 8; ++e) { const int p = ht + 256 * e; const int fr_ = p >> 6, ln = p & 63, qq = ln >> 4, cc = ln & 15;
            const int vs = fr_ >> 2, mi = fr_ & 3, v = 16 * vs + cc, i = 16 * mi + 4 * qq;
            __builtin_nontemporal_store(*(const LAS v2u*)(LB + DP_R1 + (v * 72 + i) * 2), (v2u*)(rec + REC_U + (size_t)p * 8)); }
        if (ht == 0) *(float*)(rec + REC_GE) = __expf(GS[256]);
    }
    __syncthreads();
}
constexpr int SC_A0 = 0, SC_A1 = 57344, SC_OB = 114688;
DI void scan_block(const Args& A, Frame& F, int li, int bh) {
    const int tid = fresh_tid(); const int lane = tid & 63, vs = __builtin_amdgcn_readfirstlane(tid >> 6);
    const int b = bh >> 2, h = bh & 3, fq = lane >> 4, fc_ = lane & 15;
    const unsigned char* rec0 = F.pREC() + (size_t)(bh * 32) * RECSZ;
    const bool zfrag = vs == 1 || vs == 3;
    f32x4 Hf[8]; bf16x8 Hb[4];
#pragma unroll
    for (int k = 0; k < 8; ++k) Hf[k] = (f32x4){0.f, 0.f, 0.f, 0.f};
#pragma unroll
    for (int k = 0; k < 4; ++k) Hb[k] = (bf16x8){0, 0, 0, 0, 0, 0, 0, 0};
#pragma unroll
    for (int e = 0; e < 7; ++e) { const int p = tid + 512 * e; *(LAS v4u*)(F.lds + SC_A0 + p * 16) = *(const v4u*)(rec0 + (size_t)p * 16); }
    LAS float* OB = (LAS float*)(F.lds + SC_OB);
    const int gi = tid >> 3, gc_ = tid & 7;
    const bf16* zbase = F.pRAW() + (size_t)(b * SEQ + gi) * NABP + 2048 + 128 * h + 16 * gc_;
    v2u un[4]; float gen; v4u zn0, zn1;
#pragma unroll
    for (int mi = 0; mi < 4; ++mi) un[mi] = *(const v2u*)(rec0 + REC_U + (size_t)((vs * 4 + mi) * 64 + lane) * 8);
    gen = *(const float*)(rec0 + REC_GE); zn0 = *(const v4u*)zbase; zn1 = *(const v4u*)(zbase + 8);
    __syncthreads();
#pragma unroll 1
    for (int n = 0; n < 32; ++n) {
        const unsigned char* rec = rec0 + (size_t)n * RECSZ;
        LAS unsigned char* Acur = F.lds + ((n & 1) ? SC_A1 : SC_A0);
        const float ge = gen; const v4u z0 = zn0, z1 = zn1;
        f32x4 au[4];
#pragma unroll
        for (int mi = 0; mi < 4; ++mi) au[mi] = (f32x4){bflo(un[mi].x), bfhi(un[mi].x), bflo(un[mi].y), bfhi(un[mi].y)};
        v4u pre[7];
        if (n + 1 < 32) {
#pragma unroll
            for (int e = 0; e < 7; ++e) if (e != 4 || !zfrag) pre[e] = __builtin_nontemporal_load((const v4u*)(rec + RECSZ + (size_t)(tid + 512 * e) * 16));
#pragma unroll
            for (int mi = 0; mi < 4; ++mi) un[mi] = __builtin_nontemporal_load((const v2u*)(rec + RECSZ + REC_U + (size_t)((vs * 4 + mi) * 64 + lane) * 8));
            gen = *(const float*)(rec + RECSZ + REC_GE);
            zn0 = __builtin_nontemporal_load((const v4u*)(zbase + (size_t)(n + 1) * 64 * NABP)); zn1 = __builtin_nontemporal_load((const v4u*)(zbase + (size_t)(n + 1) * 64 * NABP + 8));
        }
#define LDB(dst, off) do { _Pragma("unroll") for (int e_ = 0; e_ < 8; ++e_) dst[e_] = *(const LAS bf16x8*)(Acur + (off) + (e_ * 64 + lane) * 16); asm volatile("" ::: "memory"); } while (0)
        bf16x8 fa[8], fb[8], fc[8];
        LDB(fa, REC_NEGW); LDB(fb, REC_NEGW + 8192); LDB(fc, REC_QG);
#pragma unroll
        for (int e = 0; e < 8; ++e) au[e >> 2] = MFMA16(fa[e], Hb[e & 3], au[e >> 2]);
        LDB(fa, REC_QG + 8192);
#pragma unroll
        for (int e = 0; e < 8; ++e) au[2 + (e >> 2)] = MFMA16(fb[e], Hb[e & 3], au[2 + (e >> 2)]);
        do { _Pragma("unroll") for (int e_ = 0; e_ < 8; ++e_) if (e_ != 1 && e_ != 3) fb[e_] = *(const LAS bf16x8*)(Acur + REC_AQK + (e_ * 64 + lane) * 16); asm volatile("" ::: "memory"); } while (0);
        bf16x8 ub[2];
        ub[0] = pack8(au[0], au[1]); ub[1] = pack8(au[2], au[3]);
        f32x4 ao[4];
#pragma unroll
        for (int mi = 0; mi < 4; ++mi) ao[mi] = (f32x4){0.f, 0.f, 0.f, 0.f};
#pragma unroll
        for (int e = 0; e < 8; ++e) ao[e >> 2] = MFMA16(fc[e], Hb[e & 3], ao[e >> 2]);
        LDB(fc, REC_KDT);
#pragma unroll
        for (int e = 0; e < 8; ++e) ao[2 + (e >> 2)] = MFMA16(fa[e], Hb[e & 3], ao[2 + (e >> 2)]);
        LDB(fa, REC_KDT + 8192);
#pragma unroll
        for (int e = 0; e < 8; ++e) if (e != 1 && e != 3) ao[e >> 1] = MFMA16(fb[e], ub[e & 1], ao[e >> 1]);
#pragma unroll
        for (int mi = 0; mi < 4; ++mi)
#pragma unroll
            for (int r = 0; r < 4; ++r) OB[(16 * mi + 4 * fq + r) * 132 + 16 * vs + fc_ + 0] = ao[mi][r];
#pragma unroll
        for (int kf = 0; kf < 8; ++kf) Hf[kf] = Hf[kf] * ge;
#pragma unroll
        for (int e = 0; e < 8; ++e) Hf[e >> 1] = MFMA16(fc[e], ub[e & 1], Hf[e >> 1]);
#pragma unroll
        for (int e = 0; e < 8; ++e) Hf[4 + (e >> 1)] = MFMA16(fa[e], ub[e & 1], Hf[4 + (e >> 1)]);
#undef LDB
#pragma unroll
        for (int ks = 0; ks < 4; ++ks) Hb[ks] = pack8(Hf[2 * ks], Hf[2 * ks + 1]);
        __syncthreads();
        { float o[16];
#pragma unroll
          for (int e = 0; e < 4; ++e) { const f32x4 t = *(const LAS f32x4*)(OB + gi * 132 + 16 * gc_ + 4 * e); o[4 * e] = t.x; o[4 * e + 1] = t.y; o[4 * e + 2] = t.z; o[4 * e + 3] = t.w; }
          float ss = 0.f;
#pragma unroll
          for (int e = 0; e < 16; ++e) ss += o[e] * o[e];
          ss += __shfl_xor(ss, 1); ss += __shfl_xor(ss, 2); ss += __shfl_xor(ss, 4);
          const float rstd = rsqrtf(ss * (1.f / 128.f) + EPS);
          const unsigned zw[8] = {z0.x, z0.y, z0.z, z0.w, z1.x, z1.y, z1.z, z1.w};
          unsigned ow[8];
#pragma unroll
          for (int e = 0; e < 8; ++e) ow[e] = pk2(o[2 * e] * rstd * bflo(zw[e]), o[2 * e + 1] * rstd * bfhi(zw[e]));
          bf16* dst = F.pH() + (size_t)(b * SEQ + n * 64 + gi) * D + 512 + 128 * h + 16 * gc_;
          *(v4u*)dst = (v4u){ow[0], ow[1], ow[2], ow[3]};
          *(v4u*)(dst + 8) = (v4u){ow[4], ow[5], ow[6], ow[7]};
        }
        if (n + 1 < 32) { LAS unsigned char* An = F.lds + ((n & 1) ? SC_A0 : SC_A1);
#pragma unroll
            for (int e = 0; e < 7; ++e) if (e != 4 || !zfrag) *(LAS v4u*)(An + (tid + 512 * e) * 16) = pre[e]; }
        __syncthreads();
    }
    float* op = F.out + O_DN_P + ((size_t)((li * NB + b) * NH + h) * 128) * 128;
#pragma unroll
    for (int kf = 0; kf < 8; ++kf)
#pragma unroll
        for (int r = 0; r < 4; ++r) __builtin_nontemporal_store(Hf[kf][r], &op[(size_t)(16 * kf + 4 * fq + r) * 128 + 16 * vs + fc_]);
}

constexpr int SM_QKV = 0, SM_RED = 12288, SM_OB = 20480, SM_G = 24576;
DI void sample_unit(const Args& A, Frame& F, int li, int u) {
    const int tid = fresh_tid(); const int s = u >> 2, h = u & 3, lane = tid & 63, wv = __builtin_amdgcn_readfirstlane(tid >> 6);
    LAS float* QKV = (LAS float*)(F.lds + SM_QKV); LAS float* RED = (LAS float*)(F.lds + SM_RED); LAS float* OBf = (LAS float*)(F.lds + SM_OB); LAS float* GG = (LAS float*)(F.lds + SM_G);
    const int mb = MP + 8 * s;
    const int v = tid & 127, kq = tid >> 7;
    const float* sp = F.in(4) + ((size_t)((li * NS + s) * NH + h) * 128 + 32 * kq) * 128 + v;
    float S[32];
#pragma unroll
    for (int kk = 0; kk < 32; ++kk) S[kk] = __builtin_nontemporal_load(&sp[(size_t)kk * 128]);
    if (tid < 384) {
        const int part = tid >> 7, c = tid & 127, ch = part * 512 + 128 * h + c;
        const float* cw = F.in(13) + (size_t)li * 4 * 1536 + ch;
        const float w0 = cw[0], w1 = cw[1536], w2 = cw[2 * 1536], w3 = cw[3 * 1536];
        const float* stc = F.in(3) + ((size_t)(li * NS + s) * 3) * 1536 + ch;
        float h3 = stc[0], h2 = stc[1536], h1 = stc[2 * 1536];
#pragma unroll
        for (int t = 0; t < 8; ++t) { const float cu = bf2f(F.pRAW()[(size_t)(mb + t) * NABP + 512 + ch]); const float a = w0 * h3 + w1 * h2 + w2 * h1 + w3 * cu; QKV[(part * 8 + t) * 128 + c] = siluf(a);
            if (t >= 5) F.out[O_DNC_S + ((size_t)(li * NS + s) * 3 + (t - 5)) * 1536 + ch] = cu;
            h3 = h2; h2 = h1; h1 = cu; }
    } else if (tid < 392) {
        const int t = tid - 384;
        const float bl = bf2f(F.pRAW()[(size_t)(mb + t) * NABP + 2560 + h]), al = bf2f(F.pRAW()[(size_t)(mb + t) * NABP + 2564 + h]);
        GG[t] = sigmoidf_(bl); GG[8 + t] = __expf(-__expf(F.in(14)[li * 4 + h]) * softplusf_(al + F.in(15)[li * 4 + h]));
    }
    __syncthreads();
#pragma unroll
    for (int e = 0; e < 2; ++e) { const int r = 2 * wv + e; LAS float* row = QKV + r * 128; const float a = row[lane], bq = row[lane + 64];
        const float ss = wave_sum(a * a + bq * bq); const float rn = rsqrtf(ss + EPS) * (r < 8 ? 0.08838834764831845f : 1.f); row[lane] = a * rn; row[lane + 64] = bq * rn; }
    __syncthreads();
    { const float a = QKV[wv * 128 + lane] * QKV[(8 + wv) * 128 + lane] + QKV[wv * 128 + lane + 64] * QKV[(8 + wv) * 128 + lane + 64]; const float qk = wave_sum(a); if (lane == 0) GG[16 + wv] = qk; }
    __syncthreads();
#pragma unroll 1
    for (int t = 0; t < 8; ++t) {
        const LAS float* qv = QKV + t * 128 + 32 * kq; const LAS float* kv = QKV + (8 + t) * 128 + 32 * kq;
        float pk = 0.f, pq = 0.f; float kreg[32];
#pragma unroll
        for (int k4 = 0; k4 < 8; ++k4) { const f32x4 kk4 = *(const LAS f32x4*)(kv + 4 * k4), qq4 = *(const LAS f32x4*)(qv + 4 * k4);
#pragma unroll
            for (int e = 0; e < 4; ++e) { kreg[4 * k4 + e] = kk4[e]; pk += kk4[e] * S[4 * k4 + e]; pq += qq4[e] * S[4 * k4 + e]; } }
        LAS float* rd = RED + (t & 1) * 1024;
        rd[kq * 128 + v] = pk; rd[512 + kq * 128 + v] = pq;
        __syncthreads();
        const float kS = (rd[v] + rd[128 + v]) + (rd[256 + v] + rd[384 + v]);
        const float qS = (rd[512 + v] + rd[640 + v]) + (rd[768 + v] + rd[896 + v]);
        const float gam = GG[8 + t], beta = GG[t], qk = GG[16 + t];
        const float uu = beta * (QKV[(16 + t) * 128 + v] - gam * kS);
        if (kq == 0) OBf[t * 128 + v] = gam * qS + qk * uu;
#pragma unroll
        for (int kk = 0; kk < 32; ++kk) S[kk] = gam * S[kk] + kreg[kk] * uu;
    }
    float* so = F.out + O_DN_S + ((size_t)((li * NS + s) * NH + h) * 128 + 32 * kq) * 128 + v;
#pragma unroll
    for (int kk = 0; kk < 32; ++kk) __builtin_nontemporal_store(S[kk], &so[(size_t)kk * 128]);
    __syncthreads();
    { const int t = wv; const float a = OBf[t * 128 + lane], bq = OBf[t * 128 + lane + 64];
      const float rstd = rsqrtf(wave_sum(a * a + bq * bq) * (1.f / 128.f) + EPS);
      const float* nw = F.in(16) + (size_t)li * 128; const size_t m = (size_t)(mb + t);
      const float z0 = bf2f(F.pRAW()[m * NABP + 2048 + 128 * h + lane]), z1 = bf2f(F.pRAW()[m * NABP + 2048 + 128 * h + lane + 64]);
      F.pH()[m * D + 512 + 128 * h + lane] = f2bf(a * rstd * z0);
      F.pH()[m * D + 512 + 128 * h + lane + 64] = f2bf(bq * rstd * z1); }
    __syncthreads();
}
struct MicroResNorm { static DI int brow(int cb, int prow) { return 64 * cb + prow; } static DI void remap(int u, int& rb, int& cb) { rb = u & 15; cb = u >> 4; } bf16* XB; bf16* SSQ;
    DI void operator()(const f32x4& a0, const f32x4& a1, int row, int col, int fq) const {
        bf16* p = XB + (size_t)row * D + col; float s = 0.f;
#pragma unroll
        for (int nf = 0; nf < 2; ++nf) { const f32x4 a = nf ? a1 : a0; const v2u o = *(const v2u*)(p + 16 * nf);
            const float t0 = bflo(o.x) + a[0], t1 = bfhi(o.x) + a[1], t2 = bflo(o.y) + a[2], t3 = bfhi(o.y) + a[3];
            s += (t0 * t0 + t1 * t1) + (t2 * t2 + t3 * t3);
            *(v2u*)(p + 16 * nf) = (v2u){pk2(t0, t1), pk2(t2, t3)}; }
        s += __shfl_xor(s, 16); s += __shfl_xor(s, 32);
        if (fq == 0) SSQ[(size_t)row * 32 + (col >> 5)] = f2bf(s);
    } };
struct MicroBf16CX { bf16* O; const bf16* SSQ;
    static DI void remap(int u, int& rb, int& cb) { const int k = u >> 8, c = u & 255; rb = c & 15; cb = k == 0 ? (c >> 4) : 16 + 2 * (c >> 4) + (k - 1); }
    static DI int brow(int cb, int prow) { if (cb < 16) return 64 * cb + prow; const int ch = 32 * (cb - 16) + 16 * (prow >> 5) + (prow & 15); return D + (ch >> 7) * 256 + ((prow >> 4) & 1) * 128 + (ch & 127); }
    DI void operator()(const f32x4& a0, const f32x4& a1, int row, int col, int fq) const {
        const bf16* sp = SSQ + (size_t)row * 32; float s = 0.f;
#pragma unroll
        for (int e = 0; e < 4; ++e) { const v4u t = *(const v4u*)(sp + 8 * e); s += (bflo(t.x) + bfhi(t.x)) + (bflo(t.y) + bfhi(t.y)) + (bflo(t.z) + bfhi(t.z)) + (bflo(t.w) + bfhi(t.w)); }
        const float rs = rsqrtf(s * (1.f / 1024.f) + EPS);
        const int cb = col >> 6;
        if (cb < 16) { bf16* p = O + (size_t)row * 2048 + col;
            *(v2u*)p = (v2u){pk2(a0[0] * rs, a0[1] * rs), pk2(a0[2] * rs, a0[3] * rs)};
            *(v2u*)(p + 16) = (v2u){pk2(a1[0] * rs, a1[1] * rs), pk2(a1[2] * rs, a1[3] * rs)};
        } else { const float r2 = rs * rs; bf16* p = O + (size_t)row * 2048 + 1024 + 32 * (cb - 16) + 16 * ((col >> 5) & 1) + (col & 15);
            *(v2u*)p = (v2u){pk2(a0[0] * a1[0] * r2, a0[1] * a1[1] * r2), pk2(a0[2] * a1[2] * r2, a0[3] * a1[3] * r2)}; }
    } };
struct MicroBf16N { bf16* O; int ldc; const bf16* SSQ;
    static DI void remap(int u, int& rb, int& cb) { rb = u & 15; cb = u >> 4; }
    static DI int brow(int cb, int prow) { return 64 * cb + prow; }
    DI void operator()(const f32x4& a0, const f32x4& a1, int row, int col, int fq) const {
        const bf16* sp = SSQ + (size_t)row * 32; float s = 0.f;
#pragma unroll
        for (int e = 0; e < 4; ++e) { const v4u t = *(const v4u*)(sp + 8 * e); s += (bflo(t.x) + bfhi(t.x)) + (bflo(t.y) + bfhi(t.y)) + (bflo(t.z) + bfhi(t.z)) + (bflo(t.w) + bfhi(t.w)); }
        const float rs = rsqrtf(s * (1.f / 1024.f) + EPS);
        bf16* p = O + (size_t)row * ldc + col;
        *(v2u*)p = (v2u){pk2(a0[0] * rs, a0[1] * rs), pk2(a0[2] * rs, a0[3] * rs)};
        *(v2u*)(p + 16) = (v2u){pk2(a1[0] * rs, a1[1] * rs), pk2(a1[2] * rs, a1[3] * rs)};
    } };
template <class Epi>
DI void micro_phase(Frame& F, const bf16* Am, const bf16* Bt, int K, int N, const Epi& E) {
    const int tid = fresh_tid(); const int lane = tid & 63, wv = __builtin_amdgcn_readfirstlane(tid >> 6), fr = lane & 15, fq = lane >> 4;
    const int mi = wv & 3, nh = wv >> 2;
    const int nunits = 16 * (N >> 6), nchunk = K >> 6;
    LAS unsigned char* ring = F.lds;
    const int prow = tid >> 3, pseg = (tid & 7) ^ (prow & 7);
    int aoff[2], boff[2][2];
#pragma unroll
    for (int ks = 0; ks < 2; ++ks) { const int seg = 4 * ks + fq; { const int r = 16 * mi + fr; aoff[ks] = r * 128 + ((seg ^ (r & 7)) << 4); }
#pragma unroll
        for (int nf = 0; nf < 2; ++nf) { const int r = 32 * nh + 16 * nf + fr; boff[nf][ks] = 8192 + r * 128 + ((seg ^ (r & 7)) << 4); } }
#pragma unroll 1
    for (int u = F.bid; u < nunits; u += F.G) {
        int rb, cb; Epi::remap(u, rb, cb);
        const bf16* ga = Am + (size_t)(MP + 64 * rb + prow) * K + 8 * pseg;
        const bf16* gb = Bt + (size_t)Epi::brow(cb, prow) * K + 8 * pseg;
#define MICRO_ISSUE(c) do { LAS unsigned char* s_ = ring + (((c) & 7) << 14) + (wv << 10); \
        __builtin_amdgcn_global_load_lds((const unsigned*)(ga + ((c) << 6)), (LAS unsigned*)s_, 16, 0, 0); \
        __builtin_amdgcn_global_load_lds((const unsigned*)(gb + ((c) << 6)), (LAS unsigned*)(s_ + 8192), 16, 0, 0); } while (0)
        for (int c = 0; c < 6 && c < nchunk; ++c) MICRO_ISSUE(c);
        f32x4 acc0 = {0.f, 0.f, 0.f, 0.f}, acc1 = {0.f, 0.f, 0.f, 0.f};
#pragma unroll 1
        for (int c = 0; c < nchunk; ++c) {
            if (c + 6 <= nchunk) asm volatile("s_waitcnt vmcnt(10)" ::: "memory"); else asm volatile("s_waitcnt vmcnt(0)" ::: "memory");
            __builtin_amdgcn_s_barrier(); asm volatile("" ::: "memory");
            const LAS unsigned char* sl = ring + ((c & 7) << 14);
            const bf16x8 a0 = *(const LAS bf16x8*)(sl + aoff[0]), a1 = *(const LAS bf16x8*)(sl + aoff[1]);
            const bf16x8 b00 = *(const LAS bf16x8*)(sl + boff[0][0]), b01 = *(const LAS bf16x8*)(sl + boff[0][1]), b10 = *(const LAS bf16x8*)(sl + boff[1][0]), b11 = *(const LAS bf16x8*)(sl + boff[1][1]);
            acc0 = MFMA16(b00, a0, acc0); acc1 = MFMA16(b10, a0, acc1); acc0 = MFMA16(b01, a1, acc0); acc1 = MFMA16(b11, a1, acc1);
            asm volatile("s_waitcnt lgkmcnt(0)" ::: "memory");
            if (c + 6 < nchunk) MICRO_ISSUE(c + 6);
        }
#undef MICRO_ISSUE
        E(acc0, acc1, MP + 64 * rb + 16 * mi + fr, 64 * cb + 32 * nh + 4 * fq, fq);
        asm volatile("s_waitcnt vmcnt(0) lgkmcnt(0)" ::: "memory"); __builtin_amdgcn_s_barrier(); asm volatile("" ::: "memory");
    }
}

constexpr int N_PHASES = 22;
DI void decode_phase(int ph, int& l, int& sub) {
    if (ph == 0) { l = -1; sub = 0; return; }
    if (ph == N_PHASES - 1) { l = 4; sub = 0; return; }
    const int q = ph - 1;
    l = (q >= 16) ? 3 : (q >= 10) ? 2 : (q >= 6) ? 1 : 0;
    const int sq = q - ((l == 3) ? 16 : (l == 2) ? 10 : (l == 1) ? 6 : 0);
    if (l & 1) sub = sq == 0 ? 0 : (sq == 1 ? 3 : (sq == 2 ? 4 : 6));
    else sub = sq <= 4 ? sq : 6;
}
__global__ void __launch_bounds__(NTHREADS, 2) mega_fwd(Args A) {
    extern __shared__ __attribute__((aligned(16))) unsigned char lds_raw[];
    cg::grid_group grid = cg::this_grid();
    Frame F;
    F.lds = (LAS unsigned char*)lds_raw;
    F.tid = threadIdx.x; F.lane = F.tid & 63; F.wave = __builtin_amdgcn_readfirstlane(F.tid >> 6);
    F.G = gridDim.x; F.bid = blockIdx.x;
    F.z = 0; F.out = A.out; F.ws = A.ws;
    volatile LAS unsigned* MISC = (volatile LAS unsigned*)(F.lds + LDSCTL_OFF);
    for (int u = F.tid; u < (LDS_BYTES - LDSCTL_OFF) / 4; u += NTHREADS) ((LAS unsigned*)(F.lds + LDSCTL_OFF))[u] = 0u;
    __syncthreads();
    const int lo = A.ph_lo, hi = A.ph_hi < N_PHASES ? A.ph_hi : N_PHASES;
    XcdBarrier bar; bar.bar = (unsigned*)A.ws + CW_BAR; bar.x = xb_xcc_id(); bar.st = MISC + 8;
    if (blockIdx.x == 0) for (int u = F.tid; u < XCD_BAR_WORDS; u += NTHREADS) ((unsigned*)A.ws + CW_BAR)[u] = 0u;
#pragma unroll 1
    for (int ph = lo; ph < hi; ++ph) {
        { int z = 0; asm volatile("" : "+s"(z)); F.z = z;
          { int b_ = blockIdx.x, g_ = gridDim.x; asm volatile("" : "+s"(b_), "+s"(g_)); F.bid = b_; F.G = g_; }
          int t_ = threadIdx.x; asm volatile("" : "+v"(t_)); F.tid = t_; F.lane = t_ & 63; F.wave = __builtin_amdgcn_readfirstlane(t_ >> 6);
          const char AS4* ka = (const char AS4*)__builtin_amdgcn_kernarg_segment_ptr();
          F.out = *(float* const AS4*)(ka + 192 + z); F.ws = *(unsigned char* const AS4*)(ka + 200 + z); }
        int l, sub; decode_phase(ph, l, sub);
        const int i = l >> 1; const bool ab = (l & 1) == 0;
        if (l < 0) { p0_prologue(A, F); x0_phase(A, F); }
        else if (l == 4) { final_norm_phase(A, F, F.in(9)); }
        else if (sub == 0) {
            if (ab) { const bf16* Bt = F.pWinab() + (size_t)i * NABP * D;
                pg8::Gemm g{F.pXB(), Bt, M, NABP, D}; pg8::StaticOrder S; S.init(M, NABP, F.G, F.bid);
                pg8::EpiBf16N E{F.pRAW(), NABP, F.pSSQ(), (LAS float*)(F.lds + 131072 + 4096), F.lds + 131072 + 5120, F.in(16) + (size_t)i * 128, 8}; pg8::gemm_phase<pg8::EpiBf16N, pg8::StaticOrder, true, true>(F.lds, g, S, E);
            } else { const bf16* Bt = F.pWinc() + (size_t)i * NCC * D;
                pg8::Gemm g{F.pXB(), Bt, MP, NCC, D}; pg8::TripleOrder S; S.init(F.G, F.bid);
                pg8::EpiBf16CX E{F.pRAW(), F.pSSQ(), (LAS float*)(F.lds + 131072 + 4096), F.lds + 131072 + 5120}; pg8::gemm_phase<pg8::EpiBf16CX, pg8::TripleOrder, true, true>(F.lds, g, S, E);
                asm volatile("s_waitcnt vmcnt(0)" ::: "memory"); __syncthreads();
                for (int trip = F.bid; trip < 256; trip += F.G) { int pm, t; pg8::TripleOrder::owner(trip, pm, t); sconv_local_prompt(A, F, i, pm, t); }
                MicroBf16CX Em{F.pRAW(), F.pSSQ()}; micro_phase(F, F.pXB(), Bt, D, NCC, Em);
                for (int c2 = F.bid; c2 < 256; c2 += F.G) sconv_local_sample(A, F, i, c2 & 15, c2 >> 4);
            }
        }
        else if (sub == 4) {
            pg8::Gemm g{F.pXB(), F.pWup() + (size_t)l * NUP * D, M, NUP, D}; pg8::StaticOrder S; S.init(M, NUP, F.G, F.bid);
            pg8::EpiUpAct E{F.pACT(), F.pSSQ(), F.in(22) + (size_t)l * 3 * DFF, F.in(6) + (size_t)l * NS * 2 * DFF, F.out + O_FC_P + (size_t)l * NB * 2 * DFF, F.out + O_FC_S + (size_t)l * NS * 2 * DFF,
                               F.pFIX(), F.pHALO(), (LAS float*)(F.lds + 131072), (LAS float*)(F.lds + 131072 + 4096), F.lds + 131072 + 5120};
            pg8::gemm_phase<pg8::EpiUpAct, pg8::StaticOrder, true, true>(F.lds, g, S, E);
        }
        else if (sub == 3 || sub == 6) {
            const bf16* Am; const bf16* Bt; int K;
            if (sub == 3) { Am = F.pH(); Bt = (ab ? F.pWoutab() : F.pWoutc()) + (size_t)i * D * D; K = D; }
            else { Am = F.pACT(); Bt = F.pWdown() + (size_t)l * D * DFF; K = DFF; }
            pg8::Gemm g{Am, Bt, MP, D, K}; pg8::StaticOrder S; S.init(MP, D, F.G, F.bid);
            if (sub == 6) {
                pg8::Unit uu; for (int k = 0; S.next(k, uu); ++k) if ((uu.pm & 7) != 0) ffn_fix_panel(A, F, l, uu.pm);
                asm volatile("s_waitcnt vmcnt(0)" ::: "memory"); __syncthreads();
            } else if (!ab) {
                pg8::Unit uu; for (int k = 0; S.next(k, uu); ++k) if ((uu.pm & 7) != 0) sconv_fix_panel(A, F, i, uu.pm);
                asm volatile("s_waitcnt vmcnt(0)" ::: "memory"); __syncthreads();
            }
            pg8::EpiResNorm E{F.pXB(), F.pSSQ(), (LAS float*)(F.lds + 131072)}; pg8::gemm_phase<pg8::EpiResNorm, pg8::StaticOrder, true, true>(F.lds, g, S, E);
        }
        else if (sub == 1) {
            for (int r = 0;; ++r) { const int base = (r * F.G + F.bid) * 2; if (base >= 1024) break; const int unit = base + (F.tid >> 8); dnprep_round(A, F, i, unit, unit < 1024); }
        }
        else if (sub == 2) {
            if (F.bid < 32) scan_block(A, F, i, F.bid);
            else { for (int u = F.bid - 32; u < NS * NH; u += F.G - 32) sample_unit(A, F, i, u);
                   for (int u = F.bid - 32; u < 272 * 4; u += F.G - 32) pool_unit(A, F, i, u >> 2, u & 3);
                   convert_weights(A, F, (F.bid - 32) * NWAVES + F.wave, (F.G - 32) * NWAVES, l == 0 ? 1 : 2); }
        }
        if (ph + 1 < hi) { if (ph == lo) { grid.sync(); if (threadIdx.x == 0) (void)xb_add(&bar.bar[XB_XCNT(bar.x)], 1u); } else xcd_barrier(bar); }
    }
}

extern "C" void kernel_launch(void* const* d_in, const int* in_sizes, int n_in, void* d_out, int out_size, void* d_ws, size_t ws_size, hipStream_t stream) {
    static int grid = 0;
    if (grid == 0) {
        int dev = 0, cus = 0, per_cu = 0;
        (void)hipGetDevice(&dev);
        (void)hipDeviceGetAttribute(&cus, hipDeviceAttributeMultiprocessorCount, dev);
        (void)hipFuncSetAttribute((const void*)mega_fwd, hipFuncAttributeMaxDynamicSharedMemorySize, LDS_BYTES);
        (void)hipOccupancyMaxActiveBlocksPerMultiprocessor(&per_cu, (const void*)mega_fwd, NTHREADS, LDS_BYTES);
        (void)hipGetLastError();
        grid = cus;
        if (n_in != 24 || ws_size < WS_END || per_cu < 1) fprintf(stderr, "kernel_launch: n_in %d ws %zu (need %zu) per_cu %d cus %d\n", n_in, ws_size, (size_t)WS_END, per_cu, cus);
    }
    Args a{};
    for (int i = 0; i < 24; ++i) a.in[i] = (const float*)d_in[i];
    a.out = (float*)d_out; a.ws = (unsigned char*)d_ws; a.ph_lo = 0; a.ph_hi = 1000;
    void* kargs[] = {&a};
    hipError_t e = hipLaunchCooperativeKernel((const void*)mega_fwd, dim3(grid), dim3(NTHREADS), kargs, LDS_BYTES, stream);
    if (e != hipSuccess) fprintf(stderr, "cooperative launch failed: %s (grid %d)\n", hipGetErrorString(e), grid);
}
```
